# Optimizing an MI355X kernel written in HIP

```python
import jax
import jax.numpy as jnp
from jax import lax
import numpy as np

D_MODEL = 2048
BATCH = 2
SEQ = 8192
DEPTH = 4

N_META = 16
CHUNK = 64
NORM_EPS = 1e-6
NEG_BIG = -1e30
F_FLOOR = 1e-12
BRANCH_WIDTH = 1024
N_BRANCH = 3

A_HEADS = 8
A_DK = 128
A_DV = BRANCH_WIDTH // A_HEADS
B_HEADS = 4
B_DQK = 128
B_DV = BRANCH_WIDTH // B_HEADS
B_CONV = 4
C_HEADS = 16
C_DH = BRANCH_WIDTH // C_HEADS
C_DECAY_RANK = 64
C_ICLR_RANK = 64
C_LN_EPS = 64e-5

SPLITS = (
    A_HEADS * A_DK, A_HEADS * A_DK, BRANCH_WIDTH, BRANCH_WIDTH,
    B_HEADS * B_DQK, B_HEADS * B_DQK, BRANCH_WIDTH, BRANCH_WIDTH,
    B_HEADS, B_HEADS, BRANCH_WIDTH,
    BRANCH_WIDTH, BRANCH_WIDTH, BRANCH_WIDTH, C_DECAY_RANK, C_ICLR_RANK,
    BRANCH_WIDTH,
    D_MODEL, D_MODEL, D_MODEL,
)
N_IN = sum(SPLITS)
C_SHIFT_WIDTH = 3 * BRANCH_WIDTH + C_DECAY_RANK + C_ICLR_RANK

kernel_name = 'hybrid_hgrn2_mlstm_rwkv7_gated'


def rmsnorm(x, g):
    xf = x.astype(jnp.float32)
    y = xf * lax.rsqrt(jnp.mean(xf * xf, axis=-1, keepdims=True) + NORM_EPS)
    return (y * g.astype(jnp.float32)).astype(x.dtype)


def split_heads(a, n_heads):
    return a.reshape(a.shape[:-1] + (n_heads, a.shape[-1] // n_heads))


def head_rmsnorm(y, g):
    y = y * lax.rsqrt(jnp.mean(y * y, axis=-1, keepdims=True) + NORM_EPS)
    return y.reshape(y.shape[:2] + (-1,)) * g


def head_layernorm(y, g, eps):
    yc = y - jnp.mean(y, axis=-1, keepdims=True)
    y = yc * lax.rsqrt(jnp.mean(yc * yc, axis=-1, keepdims=True) + eps)
    return y.reshape(y.shape[:2] + (-1,)) * g


def split_cols(p):
    points = [int(v) for v in np.cumsum(SPLITS)[:-1]]
    return jnp.split(p, points, axis=-1)


def causal_conv(x, w):
    k = w.shape[0]
    return lax.conv_general_dilated(
        x, w[:, None, :].astype(x.dtype), window_strides=(1,), padding=[(k - 1, 0)],
        dimension_numbers=('NWC', 'WIO', 'NWC'), feature_group_count=x.shape[-1])


def causal_mask(length, strict=False):
    return jnp.tril(jnp.ones((length, length), dtype=bool), k=-1 if strict else 0)


def pair_decay(cum_t, cum_s, mask):
    m = mask[:, :, None]
    diff = cum_t[:, :, :, None, :] - cum_s[:, :, None, :, :]
    return jnp.where(m, jnp.exp(jnp.where(m, diff, 0.0)), 0.0)


def to_chunks(a):
    b, s, h, d = a.shape
    return a.reshape(b, s // CHUNK, CHUNK, h, d).transpose(1, 0, 3, 2, 4)


def run_chunked(step, state, seqs):
    meta = tuple(a[:, :N_META].transpose(0, 2, 1, 3) for a in seqs)
    real = tuple(to_chunks(a[:, N_META:]) for a in seqs)
    state, y_meta = step(state, meta)
    _, y_real = lax.scan(step, state, real)
    n_chunks, bsz, n_heads, length, dv = y_real.shape
    y_real = y_real.transpose(1, 0, 3, 2, 4).reshape(bsz, n_chunks * length, n_heads, dv)
    return jnp.concatenate([y_meta.transpose(0, 2, 1, 3), y_real], axis=1)


def hgrn2_chunk(s_mat, inp):
    q, k, log_f, v = inp
    length = q.shape[2]
    cg = jnp.cumsum(log_f, axis=2)
    att = jnp.einsum('bhtd,bhsd,bhtsd->bhts', q, k, pair_decay(cg, cg, causal_mask(length)))
    o = jnp.einsum('bhts,bhsv->bhtv', att, v) + jnp.einsum('bhtd,bhdv->bhtv', q * jnp.exp(cg), s_mat)
    tail = jnp.exp(cg[:, :, -1:] - cg)
    s_mat = jnp.exp(cg[:, :, -1])[..., None] * s_mat + jnp.einsum('bhsd,bhsv->bhdv', k * tail, v)
    return s_mat, o


def hgrn2_mixer(q_raw, f_raw, i_raw, z, lb, norm_g):
    f32 = jnp.float32
    f_raw = f_raw.astype(f32)
    q = split_heads(jax.nn.silu(q_raw.astype(f32)), A_HEADS) * A_DK ** -0.5
    k = (1.0 - lb) * jax.nn.sigmoid(-f_raw)
    log_f = jnp.log(jnp.maximum(lb + (1.0 - lb) * jax.nn.sigmoid(f_raw), F_FLOOR))
    v = split_heads(i_raw.astype(f32), A_HEADS)
    s0 = jnp.zeros((q.shape[0], A_HEADS, A_DK, A_DV), f32)
    o = run_chunked(hgrn2_chunk, s0, (q, split_heads(k, A_HEADS), split_heads(log_f, A_HEADS), v))
    return head_rmsnorm(o, norm_g) * jax.nn.silu(z.astype(f32))


def mlstm_chunk(state, inp):
    c_mat, n_vec, m_prev = state
    q, k, v, ig, lf = inp
    ig = ig[..., 0]
    length = q.shape[2]
    b = jnp.cumsum(lf[..., 0], axis=-1)
    log_w = b[:, :, :, None] - b[:, :, None, :] + ig[:, :, None, :]
    log_w = jnp.where(causal_mask(length), log_w, NEG_BIG)
    log_inter = b + m_prev[..., None]
    m_t = jnp.maximum(log_inter, jnp.max(log_w, axis=-1))
    scores = jnp.einsum('bhtd,bhsd->bhts', q, k) * jnp.exp(log_w - m_t[..., None])
    inter = jnp.exp(log_inter - m_t)
    num = jnp.einsum('bhts,bhsv->bhtv', scores, v) + inter[..., None] * jnp.einsum('bhtd,bhdv->bhtv', q, c_mat)
    den = jnp.sum(scores, axis=-1) + inter * jnp.einsum('bhtd,bhd->bht', q, n_vec)
    h = num / jnp.maximum(jnp.abs(den), jnp.exp(-m_t))[..., None]
    b_end = b[:, :, -1]
    log_s = b_end[..., None] - b + ig
    m_new = jnp.maximum(b_end + m_prev, jnp.max(log_s, axis=-1))
    w_s = jnp.exp(log_s - m_new[..., None])
    carry = jnp.exp(b_end + m_prev - m_new)
    c_mat = carry[..., None, None] * c_mat + jnp.einsum('bhs,bhsd,bhsv->bhdv', w_s, k, v)
    n_vec = carry[..., None] * n_vec + jnp.einsum('bhs,bhsd->bhd', w_s, k)
    return (c_mat, n_vec, m_new), h


def mlstm_mixer(q_raw, k_raw, v_raw, o_raw, ig_raw, fg_raw, z, conv_w, ig_b, fg_b, norm_g):
    f32 = jnp.float32
    qk = jax.nn.silu(causal_conv(jnp.concatenate([q_raw, k_raw], axis=-1).astype(f32), conv_w))
    q, k = jnp.split(qk, 2, axis=-1)
    q = split_heads(q, B_HEADS) * B_DQK ** -0.5
    k = split_heads(k, B_HEADS)
    v = split_heads(v_raw.astype(f32), B_HEADS)
    ig = (ig_raw.astype(f32) + ig_b)[..., None]
    lf = jax.nn.log_sigmoid(fg_raw.astype(f32) + fg_b)[..., None]
    bsz = q.shape[0]
    state = (jnp.zeros((bsz, B_HEADS, B_DQK, B_DV), f32), jnp.zeros((bsz, B_HEADS, B_DQK), f32),
             jnp.zeros((bsz, B_HEADS), f32))
    h = run_chunked(mlstm_chunk, state, (q, k, v, ig, lf))
    return (head_layernorm(h, norm_g, NORM_EPS) * jax.nn.sigmoid(o_raw.astype(f32))
            * jax.nn.silu(z.astype(f32)))


def rwkv7_chunk(s_mat, inp):
    r, k, v, lw, a_, b = inp
    length = r.shape[2]
    cw = jnp.cumsum(lw, axis=2)
    cw_prev = cw - lw
    d_strict = pair_decay(cw_prev, cw, causal_mask(length, strict=True))
    d_incl = pair_decay(cw, cw, causal_mask(length))
    l_ab = jnp.einsum('bhtd,bhsd,bhtsd->bhts', a_, b, d_strict)
    l_ak = jnp.einsum('bhtd,bhsd,bhtsd->bhts', a_, k, d_strict)
    rhs = (jnp.einsum('bhtd,bhdv->bhtv', a_ * jnp.exp(cw_prev), s_mat)
           + jnp.einsum('bhts,bhsv->bhtv', l_ak, v))
    u = lax.linalg.triangular_solve(jnp.eye(length, dtype=rhs.dtype) - l_ab, rhs,
                                    left_side=True, lower=True, unit_diagonal=True)
    r_b = jnp.einsum('bhtd,bhsd,bhtsd->bhts', r, b, d_incl)
    r_k = jnp.einsum('bhtd,bhsd,bhtsd->bhts', r, k, d_incl)
    y = (jnp.einsum('bhtd,bhdv->bhtv', r * jnp.exp(cw), s_mat)
         + jnp.einsum('bhts,bhsv->bhtv', r_b, u) + jnp.einsum('bhts,bhsv->bhtv', r_k, v))
    tail = jnp.exp(cw[:, :, -1:] - cw)
    s_mat = (jnp.exp(cw[:, :, -1])[..., None] * s_mat
             + jnp.einsum('bhsd,bhsv->bhdv', b * tail, u) + jnp.einsum('bhsd,bhsv->bhdv', k * tail, v))
    return s_mat, y


def rwkv7_mixer(c_r, c_k, c_v, c_wd, c_ad, z, mu, w0, w_up, a0, a_up, k_k, k_a, r_k, ln_g, ln_b):
    f32 = jnp.float32
    m = jnp.concatenate([c_r, c_k, c_v, c_wd, c_ad], axis=-1).astype(f32)
    prev = jnp.pad(m, ((0, 0), (1, 0), (0, 0)))[:, :-1]
    m = m + (prev - m) * mu
    w = BRANCH_WIDTH
    r, k, v, wd, ad = jnp.split(m, [w, 2 * w, 3 * w, 3 * w + C_DECAY_RANK], axis=-1)
    w_log = -jax.nn.softplus(-(w0 + jnp.tanh(wd) @ w_up)) - 0.5
    lw = -jnp.exp(w_log)
    a = jax.nn.sigmoid(a0 + ad @ a_up)
    kk = split_heads(k * k_k, C_HEADS)
    kk = kk / jnp.maximum(jnp.sqrt(jnp.sum(kk * kk, axis=-1, keepdims=True)), 1e-12)
    k = split_heads(k * (1.0 + (a - 1.0) * k_a), C_HEADS)
    r = split_heads(r, C_HEADS)
    v = split_heads(v, C_HEADS)
    s0 = jnp.zeros((r.shape[0], C_HEADS, C_DH, C_DH), f32)
    y = run_chunked(rwkv7_chunk, s0, (r, k, v, split_heads(lw, C_HEADS), -kk, kk * split_heads(a, C_HEADS)))
    y = head_layernorm(y, ln_g, C_LN_EPS) + ln_b
    bonus = jnp.sum(r * k * r_k.reshape(C_HEADS, C_DH), axis=-1, keepdims=True) * v
    return (y + bonus.reshape(y.shape)) * jax.nn.silu(z.astype(f32))


def setup_inputs(seed: int = 0) -> dict:
    key = jax.random.key(seed)
    ks = jax.random.split(key, 24)
    f32 = jnp.float32

    def nrm(k, shape, scale):
        return jax.random.normal(k, shape, f32) * scale

    return {
        'x': nrm(ks[0], (BATCH, SEQ, D_MODEL), 1.0),
        'meta_tokens': nrm(ks[1], (N_META, D_MODEL), 1.0),
        'norm_g': 1.0 + nrm(ks[2], (DEPTH, D_MODEL), 0.02),
        'w_in': nrm(ks[3], (DEPTH, D_MODEL, N_IN), D_MODEL ** -0.5),
        'hgrn_lb_logits': nrm(ks[4], (DEPTH, A_HEADS * A_DK), 0.5),
        'hgrn_norm_g': 1.0 + nrm(ks[5], (DEPTH, BRANCH_WIDTH), 0.02),
        'mlstm_conv': nrm(ks[6], (DEPTH, B_CONV, 2 * B_HEADS * B_DQK), B_CONV ** -0.5),
        'mlstm_ig_b': nrm(ks[7], (DEPTH, B_HEADS), 0.1),
        'mlstm_fg_b': jnp.linspace(3.0, 6.0, B_HEADS, dtype=f32)[None] + nrm(ks[8], (DEPTH, B_HEADS), 0.1),
        'mlstm_norm_g': 1.0 + nrm(ks[9], (DEPTH, BRANCH_WIDTH), 0.02),
        'rwkv_mu': jax.random.uniform(ks[10], (DEPTH, C_SHIFT_WIDTH), f32),
        'rwkv_w0': jnp.linspace(-6.0, -1.0, BRANCH_WIDTH, dtype=f32)[None] + nrm(ks[11], (DEPTH, BRANCH_WIDTH), 0.1),
        'rwkv_w_up': nrm(ks[12], (DEPTH, C_DECAY_RANK, BRANCH_WIDTH), 0.5 * C_DECAY_RANK ** -0.5),
        'rwkv_a0': nrm(ks[13], (DEPTH, BRANCH_WIDTH), 0.1),
        'rwkv_a_up': nrm(ks[14], (DEPTH, C_ICLR_RANK, BRANCH_WIDTH), 0.5 * C_ICLR_RANK ** -0.5),
        'rwkv_k_k': 0.85 + nrm(ks[15], (DEPTH, BRANCH_WIDTH), 0.02),
        'rwkv_k_a': 1.0 + nrm(ks[16], (DEPTH, BRANCH_WIDTH), 0.02),
        'rwkv_r_k': nrm(ks[17], (DEPTH, BRANCH_WIDTH), 0.1),
        'rwkv_ln_g': 1.0 + nrm(ks[18], (DEPTH, BRANCH_WIDTH), 0.02),
        'rwkv_ln_b': nrm(ks[19], (DEPTH, BRANCH_WIDTH), 0.02),
        'w_br': nrm(ks[20], (DEPTH, N_BRANCH, BRANCH_WIDTH, D_MODEL), BRANCH_WIDTH ** -0.5),
        'w_out': nrm(ks[21], (DEPTH, D_MODEL, D_MODEL), D_MODEL ** -0.5),
        'final_norm_g': 1.0 + nrm(ks[22], (D_MODEL,), 0.02),
    }


def reference(x, meta_tokens, norm_g, w_in, hgrn_lb_logits, hgrn_norm_g, mlstm_conv, mlstm_ig_b,
              mlstm_fg_b, mlstm_norm_g, rwkv_mu, rwkv_w0, rwkv_w_up, rwkv_a0, rwkv_a_up, rwkv_k_k,
              rwkv_k_a, rwkv_r_k, rwkv_ln_g, rwkv_ln_b, w_br, w_out, final_norm_g):
    dt = x.dtype
    bsz = x.shape[0]
    meta = jnp.broadcast_to(meta_tokens[None].astype(dt), (bsz, N_META, D_MODEL))
    h = jnp.concatenate([meta, x], axis=1)
    p = jax.nn.softmax(hgrn_lb_logits.astype(jnp.float32), axis=0)
    lower_bounds = jnp.cumsum(p, axis=0) - p[0]
    for l in range(DEPTH):
        xn = rmsnorm(h, norm_g[l])
        (a_q, a_f, a_i, a_z, b_q, b_k, b_v, b_o, b_ig, b_fg, b_z,
         c_r, c_k, c_v, c_wd, c_ad, c_z, g_a, g_b, g_c) = split_cols(xn @ w_in[l])
        y_a = hgrn2_mixer(a_q, a_f, a_i, a_z, lower_bounds[l], hgrn_norm_g[l]).astype(dt)
        y_b = mlstm_mixer(b_q, b_k, b_v, b_o, b_ig, b_fg, b_z, mlstm_conv[l], mlstm_ig_b[l],
                          mlstm_fg_b[l], mlstm_norm_g[l]).astype(dt)
        y_c = rwkv7_mixer(c_r, c_k, c_v, c_wd, c_ad, c_z, rwkv_mu[l], rwkv_w0[l], rwkv_w_up[l],
                          rwkv_a0[l], rwkv_a_up[l], rwkv_k_k[l], rwkv_k_a[l], rwkv_r_k[l],
                          rwkv_ln_g[l], rwkv_ln_b[l]).astype(dt)
        merged = (jax.nn.sigmoid(g_a) * (y_a @ w_br[l, 0])
                  + jax.nn.sigmoid(g_b) * (y_b @ w_br[l, 1])
                  + jax.nn.sigmoid(g_c) * (y_c @ w_br[l, 2]))
        h = h + merged @ w_out[l]
    return rmsnorm(h, final_norm_g)[:, N_META:]
```

```cpp
#include <hip/hip_runtime.h>
#include <hip/hip_cooperative_groups.h>
#include <cstdio>
namespace cg = cooperative_groups;

#define LAS __attribute__((address_space(3)))
typedef unsigned short bf16_t;
typedef short bf16x8 __attribute__((ext_vector_type(8)));
typedef float f32x4 __attribute__((ext_vector_type(4)));
typedef float f32x2 __attribute__((ext_vector_type(2)));
typedef unsigned u32x4 __attribute__((ext_vector_type(4)));
typedef unsigned u32x2 __attribute__((ext_vector_type(2)));

constexpr int D = 2048, NB = 2, SEQ = 8192, DEPTH = 4, NMETA = 16;
constexpr int T = SEQ + NMETA;
constexpr int M = NB * T;
constexpr int MP = 16640;
constexpr int NIN = 18568, NP = 18688;
constexpr int NTHREADS = 512, NWAVES = 8;
constexpr int C_AQ = 0, C_AF = 1024, C_AI = 2048, C_AZ = 3072, C_BQ = 4096, C_BK = 4608, C_BV = 5120, C_BO = 6144, C_BZ = 7168;
constexpr int C_CR = 8192, C_CK = 9216, C_CV = 10240, C_CZ = 11264, C_G = 12288, C_WD = 18432, C_AD = 18496, C_IG = 18560;

constexpr size_t al256(size_t x) { return (x + 255) & ~(size_t)255; }
constexpr size_t WS_WINT = 0;
constexpr size_t WS_WBRT = WS_WINT + al256((size_t)DEPTH * NP * D * 2);
constexpr size_t WS_WOUTT = WS_WBRT + al256((size_t)DEPTH * 3 * D * 1024 * 2);
constexpr size_t WS_WLRT = WS_WOUTT + al256((size_t)DEPTH * D * D * 2);
constexpr size_t WS_LB = WS_WLRT + al256((size_t)DEPTH * 2048 * 256 * 2);
constexpr size_t WS_H = WS_LB + al256((size_t)DEPTH * 1024 * 4);
constexpr size_t WS_XN = WS_H + al256((size_t)MP * D * 4);
constexpr size_t WS_PROJ = WS_XN + al256((size_t)MP * D * 2);
constexpr size_t WS_AF = WS_PROJ + al256((size_t)MP * NP * 2);
constexpr size_t WS_IGFG = WS_AF + al256((size_t)MP * 1024 * 4);
constexpr size_t WS_BQK = WS_IGFG + al256((size_t)MP * 8 * 4);
constexpr size_t WS_IL = WS_BQK + al256((size_t)MP * 1024 * 2);
constexpr size_t WS_CRKV = WS_IL + al256((size_t)MP * 8 * 4);
constexpr size_t WS_ALR = WS_CRKV + al256((size_t)MP * 3072 * 2);
constexpr size_t WS_CW = WS_ALR + al256((size_t)MP * 256 * 2);
constexpr size_t WS_CA = WS_CW + al256((size_t)MP * 1024 * 4);
constexpr size_t WS_ORAW = WS_CA + al256((size_t)MP * 1024 * 4);
constexpr size_t WS_DEN = WS_ORAW + al256((size_t)MP * 3072 * 4);
constexpr size_t WS_MST = WS_DEN + al256((size_t)MP * 4 * 4);
constexpr size_t WS_Y = WS_MST + al256((size_t)MP * 4 * 4);
constexpr size_t WS_MACC = WS_Y + al256((size_t)3 * MP * 1024 * 2);
constexpr size_t WS_MERGED = WS_MACC + al256((size_t)MP * D * 4);
constexpr size_t WS_END = WS_MERGED + al256((size_t)MP * D * 2);

constexpr int LDS_BYTES = 131072;

__device__ __forceinline__ unsigned cvt_pk_bf16(float lo, float hi) { unsigned r; asm volatile("v_cvt_pk_bf16_f32 %0, %1, %2" : "=v"(r) : "v"(lo), "v"(hi)); return r; }
__device__ __forceinline__ float bflo(unsigned u) { return __uint_as_float(u << 16); }
__device__ __forceinline__ float bfhi(unsigned u) { return __uint_as_float(u & 0xffff0000u); }
__device__ __forceinline__ float sigmoidf_(float x) { return 1.0f / (1.0f + __expf(-x)); }
__device__ __forceinline__ float siluf_(float x) { return x / (1.0f + __expf(-x)); }
__device__ __forceinline__ void unpack8(const u32x4 u, float (&f)[8]) {
    f[0] = bflo(u.x); f[1] = bfhi(u.x); f[2] = bflo(u.y); f[3] = bfhi(u.y); f[4] = bflo(u.z); f[5] = bfhi(u.z); f[6] = bflo(u.w); f[7] = bfhi(u.w);
}
__device__ __forceinline__ u32x4 pack8(const float (&f)[8]) {
    u32x4 o; o.x = cvt_pk_bf16(f[0], f[1]); o.y = cvt_pk_bf16(f[2], f[3]); o.z = cvt_pk_bf16(f[4], f[5]); o.w = cvt_pk_bf16(f[6], f[7]); return o;
}
template <int CTRL> __device__ __forceinline__ float dpp_f(float v) { return __int_as_float(__builtin_amdgcn_update_dpp(0, __float_as_int(v), CTRL, 0xf, 0xf, false)); }
__device__ __forceinline__ float row_sum16(float v) {
    v += dpp_f<0x128>(v);
    v += dpp_f<0x124>(v);
    v += dpp_f<0x122>(v);
    v += dpp_f<0x121>(v);
    return v;
}
__device__ __forceinline__ float wave_sum(float v) {
#pragma unroll
    for (int o = 1; o < 64; o <<= 1) v += __shfl_xor(v, o);
    return v;
}
#define LDS_WAIT() asm volatile("s_waitcnt lgkmcnt(0)" ::: "memory")

namespace pg8 {
constexpr int BM = 256, BK = 64, HALF = 128, HTB = HALF * BK * 2, STAGE_BYTES = 8 * HTB, NXCD = 8, WGM = 8;
__device__ __forceinline__ int lds_byte(int r, int c) { const int st = (r >> 4) * 2 + (c >> 5), rr = r & 15, cc = c & 31, ob = rr * 64 + cc * 2; return st * 1024 + (ob ^ (((ob >> 9) & 1) << 5)); }
__device__ __forceinline__ void stage_rc(int b, int& R, int& C) { const int st = b / 1024, sb = b % 1024, swz = sb ^ (((sb >> 9) & 1) << 5); R = (st >> 1) * 16 + swz / 64; C = (st & 1) * 32 + (swz % 64) / 2; }
__device__ __forceinline__ int perm32(int rho) { const int n = rho >> 4, i = rho & 15; return 8 * (i >> 2) + 4 * n + (i & 3); }

struct Unit { int pm, pn, z; };
struct Gemm { const bf16_t* A; const bf16_t* Bt; int M, N, K; size_t zA, zB; };

struct Order {
    int nM, nN, nwg, G, c, nz;
    __device__ void init(int M_, int N_, int nz_, int G_, int c_) { nM = M_ / BM; nN = N_ / BM; nwg = nM * nN; G = G_; c = c_; nz = nz_; }
    __device__ bool next(int i, Unit& u) const {
        const int ti = i / nz; u.z = i - ti * nz;
        const long L = (long)ti * G + c; if (L >= nwg) return false;
        int wgid = (int)L; { const int q = nwg / NXCD, r = nwg % NXCD, xcd = wgid % NXCD, off = wgid / NXCD; wgid = (xcd < r ? xcd * (q + 1) : r * (q + 1) + (xcd - r) * q) + off; }
        const int nig = WGM * nN, gid = wgid / nig, fm = gid * WGM, gsz = (nM - fm) < WGM ? (nM - fm) : WGM;
        u.pm = fm + ((wgid % nig) % gsz); u.pn = (wgid % nig) / gsz; return true;
    }
};

template <class Epi>
__device__ __forceinline__ void gemm_phase(LAS unsigned char* lds, const Gemm g, const Order& S, const Epi& E) {
    int tid = threadIdx.x; asm volatile("" : "+v"(tid));
    const int wid = __builtin_amdgcn_readfirstlane(tid >> 6), lane = tid & 63, wr = wid >> 2, wc = wid & 3, fr = lane & 15, fq = lane >> 4;
    int K = g.K; asm volatile("" : "+s"(K));
    const int nt = K / BK;
    unsigned voffA[2], voffB[2];
#pragma unroll
    for (int i = 0; i < 2; ++i) { int R, C; stage_rc(tid * 16 + i * 8192, R, C); const int Rb = (R & ~31) + perm32(R & 31);
        voffA[i] = (unsigned)(R * K + C) * 2u; voffB[i] = (unsigned)(Rb * K + C) * 2u; }
    const size_t kstep = (size_t)(BK * 2);
    const size_t hstep = (size_t)HALF * K * 2;
    const size_t tstep = 2 * hstep;
    const unsigned ldsw = (unsigned)wid * 1024u;
    const int aoff = lds_byte(wr * 64 + fr, fq * 8), boff = lds_byte(wc * 32 + fr, fq * 8);
#define PG8_SA(b, h) (((b) * 2 + (h)) * HTB)
#define PG8_SB(b, h) ((4 + (b) * 2 + (h)) * HTB)
#define PG8_STAGE(bufoff, gbase, voff) do { _Pragma("unroll") for (int _i = 0; _i < 2; ++_i) \
        __builtin_amdgcn_global_load_lds((const unsigned*)((const char*)(gbase) + (voff)[_i]), (LAS unsigned*)(lds + (bufoff) + ldsw + _i * 8192), 16, 0, 0); } while (0)
#define PG8_LDA(dst, b, h) do { _Pragma("unroll") for (int m = 0; m < 4; ++m) _Pragma("unroll") for (int k = 0; k < 2; ++k) dst[m][k] = *(const LAS bf16x8*)(lds + PG8_SA(b, h) + aoff + m * 2048 + k * 1024); } while (0)
#define PG8_LDB(dst, b, h) do { _Pragma("unroll") for (int n = 0; n < 2; ++n) _Pragma("unroll") for (int k = 0; k < 2; ++k) dst[n][k] = *(const LAS bf16x8*)(lds + PG8_SB(b, h) + boff + n * 2048 + k * 1024); } while (0)
#define PG8_MMA(ai, bj, At, Bt) do { __builtin_amdgcn_s_setprio(1); _Pragma("unroll") for (int m = 0; m < 4; ++m) _Pragma("unroll") for (int n = 0; n < 2; ++n) _Pragma("unroll") for (int k = 0; k < 2; ++k) \
        acc[ai][bj][m][n] = __builtin_amdgcn_mfma_f32_16x16x32_bf16(Bt[n][k], At[m][k], acc[ai][bj][m][n], 0, 0, 0); __builtin_amdgcn_s_setprio(0); } while (0)
#define PG8_WAIT_V(n) asm volatile("s_waitcnt vmcnt(" #n ")" ::: "memory")
#define PG8_WAIT_L(n) asm volatile("s_waitcnt lgkmcnt(" #n ")" ::: "memory")
#define PG8_BAR __builtin_amdgcn_s_barrier()
#define PG8_SCHED __builtin_amdgcn_sched_barrier(0)
    Unit cur, nxt; int ui = 0;
    if (!S.next(0, cur)) return;
    f32x4 acc[2][2][4][2];
#pragma unroll
    for (int a = 0; a < 2; ++a)
#pragma unroll
        for (int b = 0; b < 2; ++b)
#pragma unroll
            for (int m = 0; m < 4; ++m)
#pragma unroll
                for (int n = 0; n < 2; ++n) acc[a][b][m][n] = (f32x4){0.f, 0.f, 0.f, 0.f};
    bf16x8 At[4][2], B0[2][2], B1[2][2];
    const char* cA = (const char*)g.A + (size_t)cur.z * g.zA + (size_t)cur.pm * tstep; const char* cB = (const char*)g.Bt + (size_t)cur.z * g.zB + (size_t)cur.pn * tstep;
    PG8_STAGE(PG8_SB(0, 0), cB, voffB); PG8_STAGE(PG8_SA(0, 0), cA, voffA); PG8_STAGE(PG8_SB(0, 1), cB + hstep, voffB); PG8_STAGE(PG8_SA(0, 1), cA + hstep, voffA);
    if (wr == 1) PG8_BAR;
    PG8_WAIT_V(4); PG8_BAR;
    PG8_STAGE(PG8_SB(1, 0), cB + kstep, voffB); PG8_STAGE(PG8_SA(1, 0), cA + kstep, voffA); PG8_STAGE(PG8_SB(1, 1), cB + hstep + kstep, voffB);
    PG8_WAIT_V(6); PG8_BAR;
    for (;;) {
        const bool has_next = S.next(ui + 1, nxt);
        const char* nA = has_next ? (const char*)g.A + (size_t)nxt.z * g.zA + (size_t)nxt.pm * tstep : cA; const char* nB = has_next ? (const char*)g.Bt + (size_t)nxt.z * g.zB + (size_t)nxt.pn * tstep : cB;
        for (int t = 0; t < nt; t += 2) {
            const bool last = (t == nt - 2);
            const char* a1 = cA + (size_t)(t + 1) * kstep;
            const char* a2 = last ? nA : cA + (size_t)(t + 2) * kstep; const char* b2 = last ? nB : cB + (size_t)(t + 2) * kstep;
            const char* a3 = a2 + kstep; const char* b3 = b2 + kstep;
            PG8_LDB(B0, 0, 0); PG8_SCHED; PG8_LDA(At, 0, 0); PG8_STAGE(PG8_SA(1, 1), a1 + hstep, voffA);
            PG8_WAIT_L(8); PG8_BAR; PG8_WAIT_L(0); PG8_MMA(0, 0, At, B0); PG8_BAR; PG8_SCHED;
            PG8_LDB(B1, 0, 1); PG8_STAGE(PG8_SB(0, 0), b2, voffB);
            PG8_BAR; PG8_WAIT_L(0); PG8_MMA(0, 1, At, B1); PG8_BAR;
            PG8_LDA(At, 0, 1); PG8_STAGE(PG8_SA(0, 0), a2, voffA);
            PG8_BAR; PG8_WAIT_L(0); PG8_MMA(1, 0, At, B0); PG8_BAR; PG8_SCHED;
            PG8_STAGE(PG8_SB(0, 1), b2 + hstep, voffB);
            PG8_WAIT_V(6); PG8_BAR; PG8_MMA(1, 1, At, B1); PG8_BAR;
            PG8_LDB(B0, 1, 0); PG8_SCHED; PG8_LDA(At, 1, 0); PG8_STAGE(PG8_SA(0, 1), a2 + hstep, voffA);
            PG8_WAIT_L(8); PG8_BAR; PG8_WAIT_L(0); PG8_MMA(0, 0, At, B0); PG8_BAR; PG8_SCHED;
            PG8_LDB(B1, 1, 1); PG8_STAGE(PG8_SB(1, 0), b3, voffB);
            PG8_BAR; PG8_WAIT_L(0); PG8_MMA(0, 1, At, B1); PG8_BAR;
            PG8_LDA(At, 1, 1); PG8_STAGE(PG8_SA(1, 0), a3, voffA);
            PG8_BAR; PG8_WAIT_L(0); PG8_MMA(1, 0, At, B0); PG8_BAR; PG8_SCHED;
            PG8_STAGE(PG8_SB(1, 1), b3 + hstep, voffB);
            PG8_WAIT_V(6); PG8_BAR; PG8_MMA(1, 1, At, B1); PG8_BAR;
        }
        E(acc, cur, wr, wc, fr, fq);
        if (!has_next) break;
#pragma unroll
        for (int a = 0; a < 2; ++a)
#pragma unroll
            for (int b = 0; b < 2; ++b)
#pragma unroll
                for (int m = 0; m < 4; ++m)
#pragma unroll
                    for (int n = 0; n < 2; ++n) acc[a][b][m][n] = (f32x4){0.f, 0.f, 0.f, 0.f};
        cur = nxt; cA = nA; cB = nB; ++ui;
    }
    PG8_WAIT_V(0);
    if (wr == 0) PG8_BAR;
    PG8_BAR;
#undef PG8_SA
#undef PG8_SB
#undef PG8_STAGE
#undef PG8_LDA
#undef PG8_LDB
#undef PG8_MMA
#undef PG8_WAIT_V
#undef PG8_WAIT_L
#undef PG8_BAR
#undef PG8_SCHED
}
}

#define EPI_LOOP_BEGIN \
    const int row0 = u.pm * 256 + wr * 64 + fr, col0 = u.pn * 256 + wc * 32 + 8 * fq; \
    _Pragma("unroll") for (int ai = 0; ai < 2; ++ai) _Pragma("unroll") for (int m = 0; m < 4; ++m) { const int row = row0 + ai * 128 + m * 16; \
        _Pragma("unroll") for (int bj = 0; bj < 2; ++bj) { const int col = col0 + bj * 128; const f32x4 _c0 = acc[ai][bj][m][0], _c1 = acc[ai][bj][m][1]; \
            float v[8] = {_c0[0], _c0[1], _c0[2], _c0[3], _c1[0], _c1[1], _c1[2], _c1[3]};
#define EPI_LOOP_END } }

struct EpiG1 {
    bf16_t* PROJ; float* AF; float* IGFG; const float* LBl;
    __device__ __forceinline__ void operator()(const f32x4 (&acc)[2][2][4][2], const pg8::Unit& u, int wr, int wc, int fr, int fq) const {
        const int pn = u.pn;
        int kind;
        if (pn < 4) kind = 3; else if (pn < 8) kind = 4; else if (pn < 12) kind = 0; else if (pn < 16) kind = 1; else if (pn < 24) kind = 0; else if (pn < 28) kind = 2;
        else if (pn < 32) kind = 1; else if (pn < 44) kind = 0; else if (pn < 48) kind = 1; else if (pn < 72) kind = 2; else kind = 5;
        EPI_LOOP_BEGIN
            if (kind == 1) {
#pragma unroll
                for (int i = 0; i < 8; ++i) v[i] = siluf_(v[i]);
            } else if (kind == 2) {
#pragma unroll
                for (int i = 0; i < 8; ++i) v[i] = sigmoidf_(v[i]);
            } else if (kind == 3) {
#pragma unroll
                for (int i = 0; i < 8; ++i) v[i] = siluf_(v[i]) * 0.08838834764831845f;
            } else if (kind == 4) {
                const int c = col - C_AF;
                const f32x4 l0 = *(const f32x4*)(LBl + c), l1 = *(const f32x4*)(LBl + c + 4);
                const float lb[8] = {l0[0], l0[1], l0[2], l0[3], l1[0], l1[1], l1[2], l1[3]};
                float f[8];
#pragma unroll
                for (int i = 0; i < 8; ++i) { const float s = sigmoidf_(v[i]); f[i] = fmaxf(lb[i] + (1.0f - lb[i]) * s, 1e-12f); v[i] = (1.0f - lb[i]) * (1.0f - s); }
                float* fp = AF + (size_t)row * 1024 + c;
                *(f32x4*)fp = (f32x4){f[0], f[1], f[2], f[3]}; *(f32x4*)(fp + 4) = (f32x4){f[4], f[5], f[6], f[7]};
            } else if (kind == 5) {
                if (col == C_IG) { float* fp = IGFG + (size_t)row * 8; *(f32x4*)fp = (f32x4){v[0], v[1], v[2], v[3]}; *(f32x4*)(fp + 4) = (f32x4){v[4], v[5], v[6], v[7]}; }
            }
            *(u32x4*)(PROJ + (size_t)row * NP + col) = pack8(v);
        EPI_LOOP_END
    }
};
struct EpiLR {
    float* CW; float* CA; const float* w0; const float* a0;
    __device__ __forceinline__ void operator()(const f32x4 (&acc)[2][2][4][2], const pg8::Unit& u, int wr, int wc, int fr, int fq) const {
        const bool isw = u.pn < 4;
        const float* pb = isw ? w0 : a0 - 1024;
        float* ob = isw ? CW : CA - 1024;
        EPI_LOOP_BEGIN
            const f32x4 p0 = *(const f32x4*)(pb + col), p1 = *(const f32x4*)(pb + col + 4);
            const float p[8] = {p0[0], p0[1], p0[2], p0[3], p1[0], p1[1], p1[2], p1[3]};
            float o[8];
#pragma unroll
            for (int i = 0; i < 8; ++i) { o[i] = sigmoidf_(p[i] + v[i]); if (isw) o[i] = __expf(-0.6065306597126334f * o[i]); }
            float* fp = ob + (size_t)row * 1024 + col;
            *(f32x4*)fp = (f32x4){o[0], o[1], o[2], o[3]}; *(f32x4*)(fp + 4) = (f32x4){o[4], o[5], o[6], o[7]};
            __builtin_amdgcn_sched_barrier(0);
        EPI_LOOP_END
    }
};
struct EpiG2 {
    const bf16_t* PROJ; float* MACC; bf16_t* MERGED;
    __device__ __forceinline__ void operator()(const f32x4 (&acc)[2][2][4][2], const pg8::Unit& u, int wr, int wc, int fr, int fq) const {
        const int z = u.z;
        EPI_LOOP_BEGIN
            float g[8]; unpack8(*(const u32x4*)(PROJ + (size_t)row * NP + C_G + z * 2048 + col), g);
            float* mp = MACC + (size_t)row * D + col;
            if (z == 0) {
#pragma unroll
                for (int i = 0; i < 8; ++i) v[i] *= g[i];
            } else {
                const f32x4 m0 = *(const f32x4*)mp, m1 = *(const f32x4*)(mp + 4);
                const float mm[8] = {m0[0], m0[1], m0[2], m0[3], m1[0], m1[1], m1[2], m1[3]};
#pragma unroll
                for (int i = 0; i < 8; ++i) v[i] = mm[i] + v[i] * g[i];
            }
            if (z < 2) { *(f32x4*)mp = (f32x4){v[0], v[1], v[2], v[3]}; *(f32x4*)(mp + 4) = (f32x4){v[4], v[5], v[6], v[7]}; }
            else *(u32x4*)(MERGED + (size_t)row * D + col) = pack8(v);
        EPI_LOOP_END
    }
};
struct EpiG3 {
    float* H;
    __device__ __forceinline__ void operator()(const f32x4 (&acc)[2][2][4][2], const pg8::Unit& u, int wr, int wc, int fr, int fq) const {
        EPI_LOOP_BEGIN
            float* hp = H + (size_t)row * D + col;
            const f32x4 h0 = *(const f32x4*)hp, h1 = *(const f32x4*)(hp + 4);
            *(f32x4*)hp = (f32x4){h0[0] + v[0], h0[1] + v[1], h0[2] + v[2], h0[3] + v[3]};
            *(f32x4*)(hp + 4) = (f32x4){h1[0] + v[4], h1[1] + v[5], h1[2] + v[6], h1[3] + v[7]};
        EPI_LOOP_END
    }
};

__device__ __forceinline__ int win_dest_row(int c) {
    if (c < 7168) return c;
    if (c < 7176) return C_IG + (c - 7168);
    if (c < 11272) return c - 8;
    if (c < 11400) return C_WD + (c - 11272);
    return c - 136;
}
template <bool WIN>
__device__ __forceinline__ void transpose_item(const float* W, int K, int N, bf16_t* WT, LAS float* scr, int item, int lane) {
    const int nblk = (N + 31) / 32, kb = item / nblk, nb = item % nblk, k0 = 64 * kb, n0 = 32 * nb;
    const int nn = n0 + (lane & 31);
#pragma unroll 8
    for (int i = 0; i < 32; ++i) { const int kk = 2 * i + (lane >> 5); scr[kk * 33 + (lane & 31)] = (nn < N) ? W[(size_t)(k0 + kk) * N + nn] : 0.f; }
    LDS_WAIT();
    const int c = lane & 7;
#pragma unroll
    for (int j = 0; j < 4; ++j) { const int n = (lane >> 3) + 8 * j; const LAS float* s = scr + (8 * c) * 33 + n;
        u32x4 o; o.x = cvt_pk_bf16(s[0 * 33], s[1 * 33]); o.y = cvt_pk_bf16(s[2 * 33], s[3 * 33]); o.z = cvt_pk_bf16(s[4 * 33], s[5 * 33]); o.w = cvt_pk_bf16(s[6 * 33], s[7 * 33]);
        if (n0 + n < N) { const int dr = WIN ? win_dest_row(n0 + n) : (n0 + n); *(u32x4*)(WT + (size_t)dr * K + k0 + 8 * c) = o; } }
    LDS_WAIT();
}

__device__ __forceinline__ void rms_row(const float* src, float* Hrow, const float* g, bf16_t* xn, int lane) {
    f32x4 v[8]; float ss = 0.f;
#pragma unroll
    for (int j = 0; j < 8; ++j) { v[j] = *(const f32x4*)(src + 256 * j + 4 * lane); ss += (v[j][0] * v[j][0] + v[j][1] * v[j][1]) + (v[j][2] * v[j][2] + v[j][3] * v[j][3]); }
    if (Hrow) {
#pragma unroll
        for (int j = 0; j < 8; ++j) *(f32x4*)(Hrow + 256 * j + 4 * lane) = v[j];
    }
    const float rs = rsqrtf(wave_sum(ss) * (1.0f / D) + 1e-6f);
#pragma unroll
    for (int j = 0; j < 8; ++j) { const f32x4 gg = *(const f32x4*)(g + 256 * j + 4 * lane);
        u32x2 o; o.x = cvt_pk_bf16(v[j][0] * rs * gg[0], v[j][1] * rs * gg[1]); o.y = cvt_pk_bf16(v[j][2] * rs * gg[2], v[j][3] * rs * gg[3]);
        *(u32x2*)(xn + 256 * j + 4 * lane) = o; }
}

struct Args { const float* in[23]; float* out; unsigned char* ws; };

constexpr int TB = 32, NBLK = (T + TB - 1) / TB;
constexpr int ST_FLOATS = 13312;
constexpr int OB_OFF = 2 * ST_FLOATS;
constexpr int MB_OFF = OB_OFF + 2 * 1024;

__device__ __forceinline__ void mix_hgrn(LAS float* L, const bf16_t* PROJ, const float* AF, float* ORAW, int bh, int cb) {
    const int b = bh >> 3, h = bh & 7;
    int tid = threadIdx.x; asm volatile("" : "+v"(tid));
    const int wave = tid >> 6, lane = tid & 63, c = lane >> 4, dg = lane & 15, colw = wave * 4 + c;
    const int st = tid >> 4, sd = tid & 15;
    const size_t rowbase = (size_t)b * T;
    float S[8];
#pragma unroll
    for (int i = 0; i < 8; ++i) S[i] = 0.f;
    u32x4 rq, rk; f32x4 rf0, rf1; unsigned rv;
#define HG_LOAD(blk) do { int tt = (blk) * TB + st; tt = tt < T ? tt : T - 1; const size_t row = rowbase + tt; const bf16_t* pr = PROJ + row * NP; \
        rq = *(const u32x4*)(pr + C_AQ + h * 128 + sd * 8); rk = *(const u32x4*)(pr + C_AF + h * 128 + sd * 8); \
        const float* fp = AF + row * 1024 + h * 128 + sd * 8; rf0 = *(const f32x4*)fp; rf1 = *(const f32x4*)(fp + 4); \
        rv = *(const unsigned*)(pr + C_AI + h * 128 + cb * 32 + sd * 2); } while (0)
#define HG_WRITE(sb) do { LAS float* B = L + (sb) * ST_FLOATS; float t8[8]; \
        unpack8(rq, t8); *(LAS f32x4*)(B + st * 128 + sd * 8) = (f32x4){t8[0], t8[1], t8[2], t8[3]}; *(LAS f32x4*)(B + st * 128 + sd * 8 + 4) = (f32x4){t8[4], t8[5], t8[6], t8[7]}; \
        unpack8(rk, t8); *(LAS f32x4*)(B + 4096 + st * 128 + sd * 8) = (f32x4){t8[0], t8[1], t8[2], t8[3]}; *(LAS f32x4*)(B + 4096 + st * 128 + sd * 8 + 4) = (f32x4){t8[4], t8[5], t8[6], t8[7]}; \
        *(LAS f32x4*)(B + 8192 + st * 128 + sd * 8) = rf0; *(LAS f32x4*)(B + 8192 + st * 128 + sd * 8 + 4) = rf1; \
        *(LAS f32x2*)(B + 12288 + st * 32 + sd * 2) = (f32x2){bflo(rv), bfhi(rv)}; } while (0)
    HG_LOAD(0); HG_WRITE(0);
    __syncthreads();
    for (int blk = 0; blk < NBLK; ++blk) {
        const int nv = (T - blk * TB) < TB ? (T - blk * TB) : TB;
        if (blk + 1 < NBLK) HG_LOAD(blk + 1);
        const LAS float* B = L + (blk & 1) * ST_FLOATS;
        LAS float* ob = L + OB_OFF + (blk & 1) * 1024;
#pragma unroll 4
        for (int t = 0; t < nv; ++t) {
            const f32x4 q0 = *(const LAS f32x4*)(B + t * 128 + dg * 4), q1 = *(const LAS f32x4*)(B + t * 128 + 64 + dg * 4);
            const f32x4 k0 = *(const LAS f32x4*)(B + 4096 + t * 128 + dg * 4), k1 = *(const LAS f32x4*)(B + 4096 + t * 128 + 64 + dg * 4);
            const f32x4 f0 = *(const LAS f32x4*)(B + 8192 + t * 128 + dg * 4), f1 = *(const LAS f32x4*)(B + 8192 + t * 128 + 64 + dg * 4);
            const float vv = B[12288 + t * 32 + colw];
            float a = 0.f;
#pragma unroll
            for (int i = 0; i < 4; ++i) { S[i] = f0[i] * S[i] + k0[i] * vv; a += q0[i] * S[i]; S[4 + i] = f1[i] * S[4 + i] + k1[i] * vv; a += q1[i] * S[4 + i]; }
            a = row_sum16(a);
            if (dg == 0) ob[t * 32 + colw] = a;
        }
        if (blk + 1 < NBLK) HG_WRITE((blk + 1) & 1);
        __syncthreads();
        { const int tt = blk * TB + st; if (tt < T) *(f32x2*)(ORAW + (rowbase + tt) * 3072 + h * 128 + cb * 32 + sd * 2) = *(const LAS f32x2*)(ob + st * 32 + sd * 2); }
    }
    __syncthreads();
#undef HG_LOAD
#undef HG_WRITE
}

__device__ __forceinline__ void mix_mlstm(LAS float* L, const bf16_t* PROJ, const bf16_t* BQK, const float* IL, float* ORAW, float* DEN, float* MST, int bh, int cb) {
    const int b = bh >> 2, h = bh & 3;
    int tid = threadIdx.x; asm volatile("" : "+v"(tid));
    const int wave = tid >> 6, lane = tid & 63, c = lane >> 4, dg = lane & 15, colw = wave * 4 + c;
    const int st = tid >> 4, sd = tid & 15;
    const size_t rowbase = (size_t)b * T;
    float S[8];
#pragma unroll
    for (int i = 0; i < 8; ++i) S[i] = 0.f;
    float mrun = 0.f;
    u32x4 rq, rk; unsigned rv = 0; float rig = 0.f, rlf = 0.f;
#define ML_LOAD(blk) do { int tt = (blk) * TB + st; tt = tt < T ? tt : T - 1; const size_t row = rowbase + tt; \
        rq = *(const u32x4*)(BQK + row * 1024 + h * 128 + sd * 8); rk = *(const u32x4*)(BQK + row * 1024 + 512 + h * 128 + sd * 8); \
        if (cb < 8) rv = *(const unsigned*)(PROJ + row * NP + C_BV + h * 256 + cb * 32 + sd * 2); \
        if (tid < TB) { int t2 = (blk) * TB + tid; t2 = t2 < T ? t2 : T - 1; const float* ip = IL + (rowbase + t2) * 8; rig = ip[h]; rlf = ip[4 + h]; } } while (0)
#define ML_WRITE(sb) do { LAS float* B = L + (sb) * ST_FLOATS; float t8[8]; \
        unpack8(rq, t8); *(LAS f32x4*)(B + st * 128 + sd * 8) = (f32x4){t8[0], t8[1], t8[2], t8[3]}; *(LAS f32x4*)(B + st * 128 + sd * 8 + 4) = (f32x4){t8[4], t8[5], t8[6], t8[7]}; \
        unpack8(rk, t8); *(LAS f32x4*)(B + 4096 + st * 128 + sd * 8) = (f32x4){t8[0], t8[1], t8[2], t8[3]}; *(LAS f32x4*)(B + 4096 + st * 128 + sd * 8 + 4) = (f32x4){t8[4], t8[5], t8[6], t8[7]}; \
        *(LAS f32x2*)(B + 12288 + st * 32 + sd * 2) = (cb < 8) ? (f32x2){bflo(rv), bfhi(rv)} : (f32x2){sd == 0 ? 1.f : 0.f, 0.f}; \
        if (tid < TB) { B[8192 + tid] = rig; B[8192 + 32 + tid] = rlf; } } while (0)
    ML_LOAD(0); ML_WRITE(0);
    __syncthreads();
    for (int blk = 0; blk < NBLK; ++blk) {
        const int nv = (T - blk * TB) < TB ? (T - blk * TB) : TB;
        if (blk + 1 < NBLK) ML_LOAD(blk + 1);
        const LAS float* B = L + (blk & 1) * ST_FLOATS;
        LAS float* ob = L + OB_OFF + (blk & 1) * 1024;
        LAS float* mb = L + MB_OFF + (blk & 1) * 32;
#pragma unroll 4
        for (int t = 0; t < nv; ++t) {
            const f32x4 q0 = *(const LAS f32x4*)(B + t * 128 + dg * 4), q1 = *(const LAS f32x4*)(B + t * 128 + 64 + dg * 4);
            const f32x4 k0 = *(const LAS f32x4*)(B + 4096 + t * 128 + dg * 4), k1 = *(const LAS f32x4*)(B + 4096 + t * 128 + 64 + dg * 4);
            const float ig = B[8192 + t], lf = B[8192 + 32 + t];
            const float mnew = fmaxf(lf + mrun, ig);
            const float fp = __expf(lf + mrun - mnew), ip = __expf(ig - mnew);
            mrun = mnew;
            const float vv = ip * B[12288 + t * 32 + colw];
            float a = 0.f;
#pragma unroll
            for (int i = 0; i < 4; ++i) { S[i] = fp * S[i] + k0[i] * vv; a += q0[i] * S[i]; S[4 + i] = fp * S[4 + i] + k1[i] * vv; a += q1[i] * S[4 + i]; }
            a = row_sum16(a);
            if (dg == 0) ob[t * 32 + colw] = a;
            if (tid == 0) mb[t] = mnew;
        }
        if (blk + 1 < NBLK) ML_WRITE((blk + 1) & 1);
        __syncthreads();
        { const int tt = blk * TB + st; if (tt < T) {
            if (cb < 8) *(f32x2*)(ORAW + (rowbase + tt) * 3072 + 1024 + h * 256 + cb * 32 + sd * 2) = *(const LAS f32x2*)(ob + st * 32 + sd * 2);
            else if (sd == 0) { DEN[(rowbase + tt) * 4 + h] = ob[st * 32]; MST[(rowbase + tt) * 4 + h] = mb[st]; } } }
    }
    __syncthreads();
#undef ML_LOAD
#undef ML_WRITE
}

__device__ __forceinline__ void mix_rwkv(LAS float* L, const bf16_t* CRKV, const float* CW, const float* CA, const float* kkp, const float* kap, float* ORAW, int bh, int cb) {
    const int b = bh >> 4, h = bh & 15;
    int tid = threadIdx.x; asm volatile("" : "+v"(tid));
    const int wave = tid >> 6, lane = tid & 63, c = lane >> 4, dg = lane & 15, colw = wave * 4 + c;
    const int st = tid >> 4, sd = tid & 15;
    const size_t rowbase = (size_t)b * T;
    float S[4];
#pragma unroll
    for (int i = 0; i < 4; ++i) S[i] = 0.f;
    const f32x4 pkk = *(const f32x4*)(kkp + h * 64 + sd * 4), pka = *(const f32x4*)(kap + h * 64 + sd * 4);
    u32x2 rr, rk; f32x4 ra, rw; unsigned rv;
#define RW_LOAD(blk) do { int tt = (blk) * TB + st; tt = tt < T ? tt : T - 1; const size_t row = rowbase + tt; const bf16_t* pr = CRKV + row * 3072; \
        rr = *(const u32x2*)(pr + h * 64 + sd * 4); rk = *(const u32x2*)(pr + 1024 + h * 64 + sd * 4); \
        ra = *(const f32x4*)(CA + row * 1024 + h * 64 + sd * 4); rw = *(const f32x4*)(CW + row * 1024 + h * 64 + sd * 4); \
        rv = *(const unsigned*)(pr + 2048 + h * 64 + cb * 32 + sd * 2); } while (0)
#define RW_WRITE(sb) do { LAS float* B = L + (sb) * ST_FLOATS; \
        const f32x4 kr = (f32x4){bflo(rk.x), bfhi(rk.x), bflo(rk.y), bfhi(rk.y)}; \
        f32x4 kk = kr * pkk; float ss = (kk[0] * kk[0] + kk[1] * kk[1]) + (kk[2] * kk[2] + kk[3] * kk[3]); ss = row_sum16(ss); \
        const float inv = 1.0f / fmaxf(sqrtf(ss), 1e-12f); kk = kk * inv; \
        *(LAS f32x4*)(B + st * 64 + sd * 4) = (f32x4){bflo(rr.x), bfhi(rr.x), bflo(rr.y), bfhi(rr.y)}; \
        *(LAS f32x4*)(B + 2048 + st * 64 + sd * 4) = rw; \
        *(LAS f32x4*)(B + 4096 + st * 64 + sd * 4) = kr * (1.0f + (ra - 1.0f) * pka); \
        *(LAS f32x4*)(B + 6144 + st * 64 + sd * 4) = -kk; \
        *(LAS f32x4*)(B + 8192 + st * 64 + sd * 4) = kk * ra; \
        *(LAS f32x2*)(B + 10240 + st * 32 + sd * 2) = (f32x2){bflo(rv), bfhi(rv)}; } while (0)
    RW_LOAD(0); RW_WRITE(0);
    __syncthreads();
    for (int blk = 0; blk < NBLK; ++blk) {
        const int nv = (T - blk * TB) < TB ? (T - blk * TB) : TB;
        if (blk + 1 < NBLK) RW_LOAD(blk + 1);
        const LAS float* B = L + (blk & 1) * ST_FLOATS;
        LAS float* ob = L + OB_OFF + (blk & 1) * 1024;
#pragma unroll 4
        for (int t = 0; t < nv; ++t) {
            const f32x4 r4 = *(const LAS f32x4*)(B + t * 64 + dg * 4), w4 = *(const LAS f32x4*)(B + 2048 + t * 64 + dg * 4), k4 = *(const LAS f32x4*)(B + 4096 + t * 64 + dg * 4);
            const f32x4 a4 = *(const LAS f32x4*)(B + 6144 + t * 64 + dg * 4), b4 = *(const LAS f32x4*)(B + 8192 + t * 64 + dg * 4);
            const float vv = B[10240 + t * 32 + colw];
            float up = (a4[0] * S[0] + a4[1] * S[1]) + (a4[2] * S[2] + a4[3] * S[3]);
            const float uu = row_sum16(up);
            float y = 0.f;
#pragma unroll
            for (int i = 0; i < 4; ++i) { S[i] = w4[i] * S[i] + b4[i] * uu + k4[i] * vv; y += r4[i] * S[i]; }
            y = row_sum16(y);
            if (dg == 0) ob[t * 32 + colw] = y;
        }
        if (blk + 1 < NBLK) RW_WRITE((blk + 1) & 1);
        __syncthreads();
        { const int tt = blk * TB + st; if (tt < T) *(f32x2*)(ORAW + (rowbase + tt) * 3072 + 2048 + h * 64 + cb * 32 + sd * 2) = *(const LAS f32x2*)(ob + st * 32 + sd * 2); }
    }
    __syncthreads();
#undef RW_LOAD
#undef RW_WRITE
}

__global__ void __launch_bounds__(NTHREADS, 2) fwd_megakernel(Args args) {
    extern __shared__ __attribute__((aligned(16))) unsigned char lds_raw[];
    cg::grid_group grid = cg::this_grid();
    LAS unsigned char* lds = (LAS unsigned char*)lds_raw;
    LAS float* ldsf = (LAS float*)lds_raw;
    const int G = gridDim.x, NGW = G * NWAVES;
    const size_t GT = (size_t)G * NTHREADS;
#define PHASE_IDS int tid = threadIdx.x; asm volatile("" : "+v"(tid)); const int lane = tid & 63, wave = tid >> 6, gw = blockIdx.x * NWAVES + wave; const size_t gt = (size_t)blockIdx.x * NTHREADS + tid; (void)lane; (void)gw; (void)gt;
    unsigned char* ws = args.ws;
    const float* x = args.in[0]; const float* meta = args.in[1]; const float* norm_g = args.in[2]; const float* w_in = args.in[3];
    const float* lb_logits = args.in[4]; const float* hgrn_g = args.in[5]; const float* mconv = args.in[6]; const float* ig_b = args.in[7];
    const float* fg_b = args.in[8]; const float* mnorm_g = args.in[9]; const float* mu = args.in[10]; const float* w0 = args.in[11];
    const float* w_up = args.in[12]; const float* a0 = args.in[13]; const float* a_up = args.in[14]; const float* k_k = args.in[15];
    const float* k_a = args.in[16]; const float* r_k = args.in[17]; const float* ln_g = args.in[18]; const float* ln_b = args.in[19];
    const float* w_br = args.in[20]; const float* w_out = args.in[21]; const float* fin_g = args.in[22];
    bf16_t* WINT = (bf16_t*)(ws + WS_WINT); bf16_t* WBRT = (bf16_t*)(ws + WS_WBRT); bf16_t* WOUTT = (bf16_t*)(ws + WS_WOUTT); bf16_t* WLRT = (bf16_t*)(ws + WS_WLRT);
    float* LB = (float*)(ws + WS_LB); float* H = (float*)(ws + WS_H); bf16_t* XN = (bf16_t*)(ws + WS_XN); bf16_t* PROJ = (bf16_t*)(ws + WS_PROJ);
    float* AF = (float*)(ws + WS_AF); float* IGFG = (float*)(ws + WS_IGFG); bf16_t* BQK = (bf16_t*)(ws + WS_BQK); float* IL = (float*)(ws + WS_IL);
    bf16_t* CRKV = (bf16_t*)(ws + WS_CRKV); bf16_t* ALR = (bf16_t*)(ws + WS_ALR); float* CW = (float*)(ws + WS_CW); float* CA = (float*)(ws + WS_CA);
    float* ORAW = (float*)(ws + WS_ORAW); float* DEN = (float*)(ws + WS_DEN); float* MST = (float*)(ws + WS_MST); bf16_t* Y = (bf16_t*)(ws + WS_Y);
    float* MACC = (float*)(ws + WS_MACC); bf16_t* MERGED = (bf16_t*)(ws + WS_MERGED);

#ifndef NO_P0
    {
        PHASE_IDS
        LAS float* scr = ldsf + wave * (64 * 33);
        constexpr int I_IN = 32 * 581, I_BR = 16 * 64, I_OUT = 32 * 64;
        constexpr int NITEMS = DEPTH * I_IN + DEPTH * 3 * I_BR + DEPTH * I_OUT;
        for (int it = gw; it < NITEMS; it += NGW) {
            int r = it;
            if (r < DEPTH * I_IN) { const int l = r / I_IN; transpose_item<true>(w_in + (size_t)l * D * NIN, D, NIN, WINT + (size_t)l * NP * D, scr, r % I_IN, lane); continue; }
            r -= DEPTH * I_IN;
            if (r < DEPTH * 3 * I_BR) { const int mi = r / I_BR; transpose_item<false>(w_br + (size_t)mi * 1024 * D, 1024, D, WBRT + (size_t)mi * D * 1024, scr, r % I_BR, lane); continue; }
            r -= DEPTH * 3 * I_BR;
            { const int l = r / I_OUT; transpose_item<false>(w_out + (size_t)l * D * D, D, D, WOUTT + (size_t)l * D * D, scr, r % I_OUT, lane); }
        }
        for (size_t i = gt; i < (size_t)DEPTH * (NP - NIN) * D / 8; i += GT) { const size_t per = (size_t)(NP - NIN) * D / 8; const size_t l = i / per, o = i % per;
            *(u32x4*)(WINT + (l * NP + NIN) * D + o * 8) = (u32x4){0u, 0u, 0u, 0u}; }
        for (size_t i = gt; i < (size_t)DEPTH * 2048 * 256; i += GT) { const int k = (int)(i & 255), n = (int)((i >> 8) & 2047), l = (int)(i >> 19);
            float v = 0.f;
            if (n < 1024) { if (k < 64) v = w_up[((size_t)l * 64 + k) * 1024 + n]; }
            else { if (k >= 64 && k < 128) v = a_up[((size_t)l * 64 + (k - 64)) * 1024 + (n - 1024)]; }
            WLRT[i] = (bf16_t)(cvt_pk_bf16(v, 0.f) & 0xffffu); }
        for (size_t i = gt; i < 1024; i += GT) { float e[4], mx = -1e30f, s = 0.f;
#pragma unroll
            for (int l = 0; l < 4; ++l) { e[l] = lb_logits[l * 1024 + i]; mx = fmaxf(mx, e[l]); }
#pragma unroll
            for (int l = 0; l < 4; ++l) { e[l] = expf(e[l] - mx); s += e[l]; }
            const float p1 = e[1] / s, p2 = e[2] / s, p3 = e[3] / s;
            LB[i] = 0.f; LB[1024 + i] = p1; LB[2048 + i] = p1 + p2; LB[3072 + i] = p1 + p2 + p3; }
        for (int r = gw; r < M; r += NGW) { const int b = r / T, t = r - b * T;
            const float* src = (t < NMETA) ? meta + (size_t)t * D : x + ((size_t)b * SEQ + (t - NMETA)) * D;
            rms_row(src, H + (size_t)r * D, norm_g, XN + (size_t)r * D, lane); }
        for (size_t i = gt; i < (size_t)(MP - M) * D / 8; i += GT) { *(u32x4*)(XN + (size_t)M * D + i * 8) = (u32x4){0u, 0u, 0u, 0u}; *(u32x4*)(MERGED + (size_t)M * D + i * 8) = (u32x4){0u, 0u, 0u, 0u}; }
        for (size_t i = gt; i < (size_t)(MP - M) * 256 / 8; i += GT) *(u32x4*)(ALR + (size_t)M * 256 + i * 8) = (u32x4){0u, 0u, 0u, 0u};
        for (size_t i = gt; i < (size_t)3 * (MP - M) * 1024 / 8; i += GT) { const size_t per = (size_t)(MP - M) * 1024 / 8; const size_t z = i / per, o = i % per;
            *(u32x4*)(Y + (z * MP + M) * 1024 + o * 8) = (u32x4){0u, 0u, 0u, 0u}; }
    }
#endif
    __syncthreads();
    grid.sync();

    for (int l = 0; l < DEPTH; ++l) {
        if (l > 0) {
            PHASE_IDS
            for (int r = gw; r < M; r += NGW) rms_row(H + (size_t)r * D, nullptr, norm_g + (size_t)l * D, XN + (size_t)r * D, lane);
            grid.sync();
        }
        {
            pg8::Gemm g{XN, WINT + (size_t)l * NP * D, MP, NP, D, 0, 0};
            pg8::Order S; S.init(MP, NP, 1, G, (int)blockIdx.x);
            EpiG1 E{PROJ, AF, IGFG, LB + l * 1024};
#ifndef NO_G1
            pg8::gemm_phase<EpiG1>(lds, g, S, E);
#endif
        }
        grid.sync();
#ifndef NO_R1
        { PHASE_IDS
        for (int r = gw; r < M; r += NGW) {
            const int b = r / T, t = r - b * T;
            const bf16_t* pr = PROJ + (size_t)r * NP;
#pragma unroll
            for (int it = 0; it < 2; ++it) {
                const int c8 = (it * 64 + lane) * 8;
                float o[8];
#pragma unroll
                for (int i = 0; i < 8; ++i) o[i] = 0.f;
#pragma unroll
                for (int j = 0; j < 4; ++j) {
                    if (t - 3 + j >= 0) {
                        float xv[8]; unpack8(*(const u32x4*)(pr - (size_t)(3 - j) * NP + C_BQ + c8), xv);
                        const float* wp = mconv + ((size_t)l * 4 + j) * 1024 + c8;
                        const f32x4 w0v = *(const f32x4*)wp, w1v = *(const f32x4*)(wp + 4);
#pragma unroll
                        for (int i = 0; i < 4; ++i) { o[i] += w0v[i] * xv[i]; o[4 + i] += w1v[i] * xv[4 + i]; }
                    }
                }
                const float sc = (c8 < 512) ? 0.08838834764831845f : 1.0f;
#pragma unroll
                for (int i = 0; i < 8; ++i) o[i] = siluf_(o[i]) * sc;
                *(u32x4*)(BQK + (size_t)r * 1024 + c8) = pack8(o);
            }
            if (lane < 8) {
                const float raw = IGFG[(size_t)r * 8 + lane];
                float o;
                if (lane < 4) o = raw + ig_b[l * 4 + lane];
                else { const float z = raw + fg_b[l * 4 + (lane - 4)]; o = fminf(z, 0.f) - log1pf(expf(-fabsf(z))); }
                IL[(size_t)r * 8 + lane] = o;
            }
#pragma unroll
            for (int it = 0; it < 6; ++it) {
                const int c8 = (it * 64 + lane) * 8;
                float cur[8], prv[8], o[8];
                unpack8(*(const u32x4*)(pr + C_CR + c8), cur);
                if (t > 0) unpack8(*(const u32x4*)(pr - NP + C_CR + c8), prv);
                else {
#pragma unroll
                    for (int i = 0; i < 8; ++i) prv[i] = 0.f;
                }
                const float* mp = mu + (size_t)l * 3200 + c8;
                const f32x4 m0 = *(const f32x4*)mp, m1 = *(const f32x4*)(mp + 4);
#pragma unroll
                for (int i = 0; i < 4; ++i) { o[i] = cur[i] + (prv[i] - cur[i]) * m0[i]; o[4 + i] = cur[4 + i] + (prv[4 + i] - cur[4 + i]) * m1[i]; }
                *(u32x4*)(CRKV + (size_t)r * 3072 + c8) = pack8(o);
            }
            if (lane < 16) {
                const int c8 = lane * 8;
                float cur[8], prv[8], o[8];
                unpack8(*(const u32x4*)(pr + C_WD + c8), cur);
                if (t > 0) unpack8(*(const u32x4*)(pr - NP + C_WD + c8), prv);
                else {
#pragma unroll
                    for (int i = 0; i < 8; ++i) prv[i] = 0.f;
                }
                const float* mp = mu + (size_t)l * 3200 + 3072 + c8;
                const f32x4 m0 = *(const f32x4*)mp, m1 = *(const f32x4*)(mp + 4);
#pragma unroll
                for (int i = 0; i < 4; ++i) { o[i] = cur[i] + (prv[i] - cur[i]) * m0[i]; o[4 + i] = cur[4 + i] + (prv[4 + i] - cur[4 + i]) * m1[i]; }
                if (lane < 8) {
#pragma unroll
                    for (int i = 0; i < 8; ++i) o[i] = tanhf(o[i]);
                }
                *(u32x4*)(ALR + (size_t)r * 256 + c8) = pack8(o);
            } else if (lane < 32) {
                *(u32x4*)(ALR + (size_t)r * 256 + lane * 8) = (u32x4){0u, 0u, 0u, 0u};
            }
        } }
#endif
        grid.sync();
        {
            pg8::Gemm g{ALR, WLRT + (size_t)l * 2048 * 256, MP, 2048, 256, 0, 0};
            pg8::Order S; S.init(MP, 2048, 1, G, (int)blockIdx.x);
            EpiLR E{CW, CA, w0 + (size_t)l * 1024, a0 + (size_t)l * 1024};
#ifndef NO_G1B
            pg8::gemm_phase<EpiLR>(lds, g, S, E);
#endif
        }
        grid.sync();
        {
            const int vcu = (G % 8 == 0) ? ((int)blockIdx.x % 8) * (G / 8) + (int)blockIdx.x / 8 : (int)blockIdx.x;
#ifndef NO_MIX
            for (int item = vcu; item < 200; item += G) {
#ifndef NO_HG
                if (item < 64) mix_hgrn(ldsf, PROJ, AF, ORAW, item >> 2, item & 3);
#else
                if (item < 64) {}
#endif
#ifndef NO_ML
                else if (item < 136) { const int i2 = item - 64; mix_mlstm(ldsf, PROJ, BQK, IL, ORAW, DEN, MST, i2 / 9, i2 % 9); }
#else
                else if (item < 136) {}
#endif
#ifndef NO_RW
                else { const int i2 = item - 136; mix_rwkv(ldsf, CRKV, CW, CA, k_k + (size_t)l * 1024, k_a + (size_t)l * 1024, ORAW, i2 >> 1, i2 & 1); }
#else
                else {}
#endif
            }
#endif
        }
        grid.sync();
#ifndef NO_NORM
        { PHASE_IDS
        for (int r = gw; r < M; r += NGW) {
            const bf16_t* pr = PROJ + (size_t)r * NP;
            const int c0 = lane * 16;
            {
                float o[16]; float ss = 0.f;
#pragma unroll
                for (int j = 0; j < 4; ++j) { const f32x4 t4 = *(const f32x4*)(ORAW + (size_t)r * 3072 + c0 + 4 * j); o[4 * j] = t4[0]; o[4 * j + 1] = t4[1]; o[4 * j + 2] = t4[2]; o[4 * j + 3] = t4[3]; }
#pragma unroll
                for (int i = 0; i < 16; ++i) ss += o[i] * o[i];
                ss += __shfl_xor(ss, 1); ss += __shfl_xor(ss, 2); ss += __shfl_xor(ss, 4);
                const float rs = rsqrtf(ss * (1.0f / 128.0f) + 1e-6f);
#pragma unroll
                for (int hh = 0; hh < 2; ++hh) {
                    float z8[8], y8[8]; unpack8(*(const u32x4*)(pr + C_AZ + c0 + 8 * hh), z8);
                    const float* gp = hgrn_g + (size_t)l * 1024 + c0 + 8 * hh;
#pragma unroll
                    for (int i = 0; i < 8; ++i) y8[i] = o[8 * hh + i] * rs * gp[i] * z8[i];
                    *(u32x4*)(Y + (size_t)r * 1024 + c0 + 8 * hh) = pack8(y8);
                }
            }
            {
                const int hd = lane >> 4;
                const float den = DEN[(size_t)r * 4 + hd], mm = MST[(size_t)r * 4 + hd];
                const float inv = 1.0f / fmaxf(fabsf(den), expf(-mm));
                float o[16]; float s1 = 0.f;
#pragma unroll
                for (int j = 0; j < 4; ++j) { const f32x4 t4 = *(const f32x4*)(ORAW + (size_t)r * 3072 + 1024 + c0 + 4 * j); o[4 * j] = t4[0] * inv; o[4 * j + 1] = t4[1] * inv; o[4 * j + 2] = t4[2] * inv; o[4 * j + 3] = t4[3] * inv; }
#pragma unroll
                for (int i = 0; i < 16; ++i) s1 += o[i];
                s1 += __shfl_xor(s1, 1); s1 += __shfl_xor(s1, 2); s1 += __shfl_xor(s1, 4); s1 += __shfl_xor(s1, 8);
                const float mean = s1 * (1.0f / 256.0f);
                float s2 = 0.f;
#pragma unroll
                for (int i = 0; i < 16; ++i) { o[i] -= mean; s2 += o[i] * o[i]; }
                s2 += __shfl_xor(s2, 1); s2 += __shfl_xor(s2, 2); s2 += __shfl_xor(s2, 4); s2 += __shfl_xor(s2, 8);
                const float rs = rsqrtf(s2 * (1.0f / 256.0f) + 1e-6f);
#pragma unroll
                for (int hh = 0; hh < 2; ++hh) {
                    float og[8], z8[8], y8[8]; unpack8(*(const u32x4*)(pr + C_BO + c0 + 8 * hh), og); unpack8(*(const u32x4*)(pr + C_BZ + c0 + 8 * hh), z8);
                    const float* gp = mnorm_g + (size_t)l * 1024 + c0 + 8 * hh;
#pragma unroll
                    for (int i = 0; i < 8; ++i) y8[i] = o[8 * hh + i] * rs * gp[i] * og[i] * z8[i];
                    *(u32x4*)(Y + ((size_t)MP + r) * 1024 + c0 + 8 * hh) = pack8(y8);
                }
            }
            {
                float o[16]; float s1 = 0.f;
#pragma unroll
                for (int j = 0; j < 4; ++j) { const f32x4 t4 = *(const f32x4*)(ORAW + (size_t)r * 3072 + 2048 + c0 + 4 * j); o[4 * j] = t4[0]; o[4 * j + 1] = t4[1]; o[4 * j + 2] = t4[2]; o[4 * j + 3] = t4[3]; }
#pragma unroll
                for (int i = 0; i < 16; ++i) s1 += o[i];
                s1 += __shfl_xor(s1, 1); s1 += __shfl_xor(s1, 2);
                const float mean = s1 * (1.0f / 64.0f);
                float s2 = 0.f;
#pragma unroll
                for (int i = 0; i < 16; ++i) { o[i] -= mean; s2 += o[i] * o[i]; }
                s2 += __shfl_xor(s2, 1); s2 += __shfl_xor(s2, 2);
                const float rs = rsqrtf(s2 * (1.0f / 64.0f) + 64e-5f);
                const bf16_t* cr = CRKV + (size_t)r * 3072;
                float rr[16], kk[16], vv[16];
#pragma unroll
                for (int hh = 0; hh < 2; ++hh) {
                    float t8[8];
                    unpack8(*(const u32x4*)(cr + c0 + 8 * hh), t8);
#pragma unroll
                    for (int i = 0; i < 8; ++i) rr[8 * hh + i] = t8[i];
                    unpack8(*(const u32x4*)(cr + 1024 + c0 + 8 * hh), t8);
#pragma unroll
                    for (int i = 0; i < 8; ++i) kk[8 * hh + i] = t8[i];
                    unpack8(*(const u32x4*)(cr + 2048 + c0 + 8 * hh), t8);
#pragma unroll
                    for (int i = 0; i < 8; ++i) vv[8 * hh + i] = t8[i];
                }
                float bs = 0.f;
#pragma unroll
                for (int i = 0; i < 16; ++i) { const float aa = CA[(size_t)r * 1024 + c0 + i]; const float kp = kk[i] * (1.0f + (aa - 1.0f) * k_a[(size_t)l * 1024 + c0 + i]);
                    bs += rr[i] * kp * r_k[(size_t)l * 1024 + c0 + i]; }
                bs += __shfl_xor(bs, 1); bs += __shfl_xor(bs, 2);
#pragma unroll
                for (int hh = 0; hh < 2; ++hh) {
                    float z8[8], y8[8]; unpack8(*(const u32x4*)(pr + C_CZ + c0 + 8 * hh), z8);
                    const float* gp = ln_g + (size_t)l * 1024 + c0 + 8 * hh; const float* bp = ln_b + (size_t)l * 1024 + c0 + 8 * hh;
#pragma unroll
                    for (int i = 0; i < 8; ++i) y8[i] = (o[8 * hh + i] * rs * gp[i] + bp[i] + bs * vv[8 * hh + i]) * z8[i];
                    *(u32x4*)(Y + ((size_t)2 * MP + r) * 1024 + c0 + 8 * hh) = pack8(y8);
                }
            }
        } }
#endif
        grid.sync();
        {
            pg8::Gemm g{Y, WBRT + (size_t)l * 3 * D * 1024, MP, D, 1024, (size_t)MP * 1024 * 2, (size_t)D * 1024 * 2};
            pg8::Order S; S.init(MP, D, 3, G, (int)blockIdx.x);
            EpiG2 E{PROJ, MACC, MERGED};
#ifndef NO_G2
            pg8::gemm_phase<EpiG2>(lds, g, S, E);
#endif
        }
        grid.sync();
        {
            pg8::Gemm g{MERGED, WOUTT + (size_t)l * D * D, MP, D, D, 0, 0};
            pg8::Order S; S.init(MP, D, 1, G, (int)blockIdx.x);
            EpiG3 E{H};
#ifndef NO_G3
            pg8::gemm_phase<EpiG3>(lds, g, S, E);
#endif
        }
        grid.sync();
    }
    PHASE_IDS
    for (int r = gw; r < M; r += NGW) {
        const int b = r / T, t = r - b * T;
        if (t < NMETA) continue;
        const float* src = H + (size_t)r * D;
        float* dst = args.out + ((size_t)b * SEQ + (t - NMETA)) * D;
        f32x4 v[8]; float ss = 0.f;
#pragma unroll
        for (int j = 0; j < 8; ++j) { v[j] = *(const f32x4*)(src + 256 * j + 4 * lane); ss += (v[j][0] * v[j][0] + v[j][1] * v[j][1]) + (v[j][2] * v[j][2] + v[j][3] * v[j][3]); }
        const float rs = rsqrtf(wave_sum(ss) * (1.0f / D) + 1e-6f);
#pragma unroll
        for (int j = 0; j < 8; ++j) { const f32x4 gg = *(const f32x4*)(fin_g + 256 * j + 4 * lane);
            *(f32x4*)(dst + 256 * j + 4 * lane) = (f32x4){v[j][0] * rs * gg[0], v[j][1] * rs * gg[1], v[j][2] * rs * gg[2], v[j][3] * rs * gg[3]}; }
    }
}

extern "C" void kernel_launch(void* const* d_in, const int* in_sizes, int n_in, void* d_out, int out_size, void* d_ws, size_t ws_size, hipStream_t stream) {
    static int grid = 0;
    if (grid == 0) {
        if (n_in != 23 || ws_size < WS_END) { fprintf(stderr, "kernel_launch: unexpected n_in %d or workspace %zu < %zu\n", n_in, ws_size, (size_t)WS_END); grid = -1; return; }
        int dev = 0, cus = 0, per_cu = 0;
        (void)hipGetDevice(&dev);
        (void)hipDeviceGetAttribute(&cus, hipDeviceAttributeMultiprocessorCount, dev);
        (void)hipFuncSetAttribute((const void*)fwd_megakernel, hipFuncAttributeMaxDynamicSharedMemorySize, LDS_BYTES);
        (void)hipOccupancyMaxActiveBlocksPerMultiprocessor(&per_cu, (const void*)fwd_megakernel, NTHREADS, LDS_BYTES);
        if (per_cu < 1) per_cu = 1;
        grid = cus * per_cu;
        fprintf(stderr, "kernel_launch: grid %d (cus %d x %d), ws %zu need %zu\n", grid, cus, per_cu, ws_size, (size_t)WS_END);
    }
    if (grid < 0) return;
    Args a{};
    for (int i = 0; i < 23; ++i) a.in[i] = (const float*)d_in[i];
    a.out = (float*)d_out; a.ws = (unsigned char*)d_ws;
    void* kargs[] = {&a};
    hipError_t e = hipLaunchCooperativeKernel((const void*)fwd_megakernel, dim3(grid), dim3(NTHREADS), kargs, LDS_BYTES, stream);
    if (e != hipSuccess) fprintf(stderr, "kernel_launch: cooperative launch failed: %s (grid %d)\n", hipGetErrorString(e), grid);
}
```

```cpp
#include <hip/hip_runtime.h>
#include <hip/hip_cooperative_groups.h>
#include <cstdio>
namespace cg = cooperative_groups;

#define LAS __attribute__((address_space(3)))
typedef unsigned short bf16_t;
typedef short bf16x8 __attribute__((ext_vector_type(8)));
typedef float f32x4 __attribute__((ext_vector_type(4)));
typedef float f32x2 __attribute__((ext_vector_type(2)));
typedef unsigned u32x4 __attribute__((ext_vector_type(4)));
typedef unsigned u32x2 __attribute__((ext_vector_type(2)));

constexpr int D = 2048, NB = 2, SEQ = 8192, DEPTH = 4, NMETA = 16;
constexpr int T = SEQ + NMETA;
constexpr int M = NB * T;
constexpr int MP = 16640;
constexpr int NIN = 18568, NP = 18688;
constexpr int NTHREADS = 512, NWAVES = 8;
constexpr int C_AQ = 0, C_AF = 1024, C_AI = 2048, C_AZ = 3072, C_BQ = 4096, C_BK = 4608, C_BV = 5120, C_BO = 6144, C_BZ = 7168;
constexpr int C_CR = 8192, C_CK = 9216, C_CV = 10240, C_CZ = 11264, C_G = 12288, C_WD = 18432, C_AD = 18496, C_IG = 18560;

constexpr size_t al256(size_t x) { return (x + 255) & ~(size_t)255; }
constexpr size_t WS_WINT = 0;
constexpr size_t WS_WBRT = WS_WINT + al256((size_t)DEPTH * NP * D * 2);
constexpr size_t WS_WOUTT = WS_WBRT + al256((size_t)DEPTH * 3 * D * 1024 * 2);
constexpr size_t WS_WLRT = WS_WOUTT + al256((size_t)DEPTH * D * D * 2);
constexpr size_t WS_LB = WS_WLRT + al256((size_t)DEPTH * 2048 * 256 * 2);
constexpr size_t WS_H = WS_LB + al256((size_t)DEPTH * 1024 * 4);
constexpr size_t WS_XN = WS_H + al256((size_t)MP * D * 4);
constexpr size_t WS_PROJ = WS_XN + al256((size_t)MP * D * 2);
constexpr size_t WS_AF = WS_PROJ + al256((size_t)MP * NP * 2);
constexpr size_t WS_IGFG = WS_AF + al256((size_t)MP * 1024 * 4);
constexpr size_t WS_BQK = WS_IGFG + al256((size_t)MP * 8 * 4);
constexpr size_t WS_IL = WS_BQK + al256((size_t)MP * 1024 * 2);
constexpr size_t WS_CRKV = WS_IL + al256((size_t)MP * 8 * 4);
constexpr size_t WS_ALR = WS_CRKV + al256((size_t)MP * 3072 * 2);
constexpr size_t WS_CW = WS_ALR + al256((size_t)MP * 256 * 2);
constexpr size_t WS_CA = WS_CW + al256((size_t)MP * 1024 * 4);
constexpr size_t WS_ORAW = WS_CA + al256((size_t)MP * 1024 * 4);
constexpr size_t WS_DEN = WS_ORAW + al256((size_t)MP * 3072 * 4);
constexpr size_t WS_MST = WS_DEN + al256((size_t)MP * 4 * 4);
constexpr size_t WS_Y = WS_MST + al256((size_t)MP * 4 * 4);
constexpr size_t WS_MACC = WS_Y + al256((size_t)3 * MP * 1024 * 2);
constexpr size_t WS_MERGED = WS_MACC + al256((size_t)MP * D * 4);
constexpr size_t WS_RWI = WS_MACC;
constexpr size_t WS_SRW = WS_MACC + (size_t)32 * 129 * 33024;
constexpr size_t WS_DS = WS_MERGED + al256((size_t)MP * D * 2);
constexpr size_t WS_DSI = WS_DS + al256((size_t)32 * 129 * 129 * 128 * 2);
constexpr size_t WS_DEC = WS_DSI + al256((size_t)32 * 129 * 129 * 128 * 2);
constexpr size_t WS_BEND = WS_DEC + al256((size_t)16 * 129 * 128 * 4);
constexpr size_t WS_MLOC = WS_BEND + al256((size_t)8 * 129 * 4);
constexpr size_t WS_MPREV = WS_MLOC + al256((size_t)8 * 129 * 4);
constexpr size_t WS_BAR = WS_MPREV + al256((size_t)8 * 129 * 4);
constexpr size_t WS_END = WS_BAR + al256((size_t)3456 * 4);

constexpr int LDS_BYTES = 131072 + 64;

typedef __bf16 bf16x2_t __attribute__((ext_vector_type(2)));
__device__ __forceinline__ unsigned cvt_pk_bf16(float lo, float hi) { const bf16x2_t r = __builtin_convertvector((f32x2){lo, hi}, bf16x2_t); return __builtin_bit_cast(unsigned, r); }
__device__ __forceinline__ float bflo(unsigned u) { return __uint_as_float(u << 16); }
__device__ __forceinline__ float bfhi(unsigned u) { return __uint_as_float(u & 0xffff0000u); }
__device__ __forceinline__ float sigmoidf_(float x) { return __builtin_amdgcn_rcpf(1.0f + __expf(-x)); }
__device__ __forceinline__ float siluf_(float x) { return x * __builtin_amdgcn_rcpf(1.0f + __expf(-x)); }
__device__ __forceinline__ void unpack8(const u32x4 u, float (&f)[8]) {
    f[0] = bflo(u.x); f[1] = bfhi(u.x); f[2] = bflo(u.y); f[3] = bfhi(u.y); f[4] = bflo(u.z); f[5] = bfhi(u.z); f[6] = bflo(u.w); f[7] = bfhi(u.w);
}
__device__ __forceinline__ u32x4 pack8(const float (&f)[8]) {
    u32x4 o; o.x = cvt_pk_bf16(f[0], f[1]); o.y = cvt_pk_bf16(f[2], f[3]); o.z = cvt_pk_bf16(f[4], f[5]); o.w = cvt_pk_bf16(f[6], f[7]); return o;
}
template <int CTRL> __device__ __forceinline__ float dpp_f(float v) { return __int_as_float(__builtin_amdgcn_update_dpp(0, __float_as_int(v), CTRL, 0xf, 0xf, false)); }
__device__ __forceinline__ float row_sum16(float v) {
    v += dpp_f<0x128>(v);
    v += dpp_f<0x124>(v);
    v += dpp_f<0x122>(v);
    v += dpp_f<0x121>(v);
    return v;
}
__device__ __forceinline__ float wave_sum(float v) {
#pragma unroll
    for (int o = 1; o < 64; o <<= 1) v += __shfl_xor(v, o);
    return v;
}
#define LDS_WAIT() asm volatile("s_waitcnt lgkmcnt(0)" ::: "memory")
#define LDS_BAR() do { asm volatile("s_waitcnt lgkmcnt(0)" ::: "memory"); __builtin_amdgcn_s_barrier(); asm volatile("" ::: "memory"); } while (0)

#define XB_TMO      128
#define XB_XCNT(j)  (256  + 64 * (j))
#define XB_XSUB(j)  (1280 + 64 * (j))
#define XB_XGEN(j)  (2304 + 64 * (j))
#define XB_TOP      3328
#define XB_TOPGEN   3392
#define XCD_BAR_WORDS 3456
#define XB_SPIN_CAP (1u << 20)
__device__ __forceinline__ unsigned xb_ld(unsigned* p)              { return __hip_atomic_load(p, __ATOMIC_RELAXED, __HIP_MEMORY_SCOPE_AGENT); }
__device__ __forceinline__ unsigned xb_add(unsigned* p, unsigned v) { return __hip_atomic_fetch_add(p, v, __ATOMIC_RELAXED, __HIP_MEMORY_SCOPE_AGENT); }
__device__ __forceinline__ unsigned xb_xcc_id() { return (unsigned)__builtin_amdgcn_s_getreg((3 << 11) | 20) & 0xFu; }
#define XB_SPIN(cond, bar) do { unsigned _sp = 0; while (cond) { __builtin_amdgcn_s_sleep(1); \
    if ((++_sp & 255u) == 0u) { if (xb_ld(&(bar)[XB_TMO])) break; if (_sp > XB_SPIN_CAP) { atomicAdd(&(bar)[XB_TMO], 1u); break; } } } } while (0)
struct XcdBarrier { unsigned* bar; unsigned x; volatile LAS unsigned* st; };
__device__ __forceinline__ XcdBarrier xcd_barrier_post(unsigned* bar, volatile LAS unsigned* st) {
    XcdBarrier b; b.bar = bar; b.x = xb_xcc_id(); b.st = st;
    if (threadIdx.x == 0) (void)xb_add(&bar[XB_XCNT(b.x)], 1u);
    return b;
}
__device__ __forceinline__ void xcd_barrier_complete(unsigned* bar, unsigned x, unsigned& nloc, unsigned& nx) {
    const unsigned G = gridDim.x * gridDim.y * gridDim.z;
    unsigned sum, cnt, mine, sp = 0u;
    for (;;) {
        sum = 0u; cnt = 0u; mine = 0u;
#pragma unroll
        for (unsigned j = 0; j < 16; ++j) { const unsigned c = xb_ld(&bar[XB_XCNT(j)]); sum += c; cnt += (c > 0u) ? 1u : 0u; mine = (j == x) ? c : mine; }
        if (sum == G) break;
        __builtin_amdgcn_s_sleep(1);
        if ((++sp & 255u) == 0u) { if (xb_ld(&bar[XB_TMO])) break; if (sp > XB_SPIN_CAP) { atomicAdd(&bar[XB_TMO], 1u); break; } }
    }
    nloc = mine > 0u ? mine : 1u; nx = cnt > 0u ? cnt : 1u;
}
__device__ __forceinline__ void xcd_barrier(const XcdBarrier& b) {
    asm volatile("s_waitcnt vmcnt(0)" ::: "memory");
    __syncthreads();
    if (threadIdx.x == 0) {
        unsigned* bar = b.bar;
        __builtin_amdgcn_s_waitcnt(0);
        unsigned nloc = b.st[0], nx = b.st[1];
        if (nloc == 0u) { xcd_barrier_complete(bar, b.x, nloc, nx); b.st[0] = nloc; b.st[1] = nx; }
        const unsigned old = xb_add(&bar[XB_XSUB(b.x)], 1u);
        const unsigned gen = old / nloc;
        if (old + 1u == (gen + 1u) * nloc) {
            __builtin_amdgcn_fence(__ATOMIC_RELEASE, "agent");
            asm volatile("s_waitcnt vmcnt(0)" ::: "memory");
            const unsigned og = xb_add(&bar[XB_TOP], 1u);
            const unsigned tg = og / nx;
            if (og + 1u == (tg + 1u) * nx) xb_add(&bar[XB_TOPGEN], 1u);
            else XB_SPIN(xb_ld(&bar[XB_TOPGEN]) == tg, bar);
            __builtin_amdgcn_fence(__ATOMIC_ACQUIRE, "agent");
            xb_add(&bar[XB_XGEN(b.x)], 1u);
            asm volatile("s_waitcnt vmcnt(0)" ::: "memory");
        } else {
            XB_SPIN(xb_ld(&bar[XB_XGEN(b.x)]) == gen, bar);
            __builtin_amdgcn_fence(__ATOMIC_ACQUIRE, "agent");
            asm volatile("s_waitcnt vmcnt(0)" ::: "memory");
        }
    }
    __syncthreads();
}

namespace pg8 {
constexpr int BM = 256, BK = 64, HALF = 128, HTB = HALF * BK * 2, STAGE_BYTES = 8 * HTB, NXCD = 8, WGM = 8;
__device__ __forceinline__ int lds_byte(int r, int c) { const int st = (r >> 4) * 2 + (c >> 5), rr = r & 15, cc = c & 31, ob = rr * 64 + cc * 2; return st * 1024 + (ob ^ (((ob >> 9) & 1) << 5)); }
__device__ __forceinline__ void stage_rc(int b, int& R, int& C) { const int st = b / 1024, sb = b % 1024, swz = sb ^ (((sb >> 9) & 1) << 5); R = (st >> 1) * 16 + swz / 64; C = (st & 1) * 32 + (swz % 64) / 2; }
__device__ __forceinline__ int perm32(int rho) { const int n = rho >> 4, i = rho & 15; return 8 * (i >> 2) + 4 * n + (i & 3); }

struct Unit { int pm, pn, z; };
struct Gemm { const bf16_t* A; const bf16_t* Bt; int M, N, K; size_t zA, zB; };

struct Order {
    int nM, nN, nwg, G, c, nz;
    __device__ void init(int M_, int N_, int nz_, int G_, int c_) { nM = M_ / BM; nN = N_ / BM; nwg = nM * nN; G = G_; c = c_; nz = nz_; }
    __device__ bool next(int i, Unit& u) const {
        const int ti = i / nz; u.z = i - ti * nz;
        const long L = (long)ti * G + c; if (L >= nwg) return false;
        int wgid = (int)L; { const int q = nwg / NXCD, r = nwg % NXCD, xcd = wgid % NXCD, off = wgid / NXCD; wgid = (xcd < r ? xcd * (q + 1) : r * (q + 1) + (xcd - r) * q) + off; }
        const int nig = WGM * nN, gid = wgid / nig, fm = gid * WGM, gsz = (nM - fm) < WGM ? (nM - fm) : WGM;
        u.pm = fm + ((wgid % nig) % gsz); u.pn = (wgid % nig) / gsz; return true;
    }
};

template <class Epi>
__device__ __forceinline__ void gemm_phase(LAS unsigned char* lds, const Gemm g, const Order& S, const Epi& E) {
    int tid = threadIdx.x; asm volatile("" : "+v"(tid));
    const int wid = __builtin_amdgcn_readfirstlane(tid >> 6), lane = tid & 63, wr = wid >> 2, wc = wid & 3, fr = lane & 15, fq = lane >> 4;
    int K = g.K; asm volatile("" : "+s"(K));
    const int nt = K / BK;
    unsigned voffA[2], voffB[2];
#pragma unroll
    for (int i = 0; i < 2; ++i) { int R, C; stage_rc(tid * 16 + i * 8192, R, C); const int Rb = (R & ~31) + perm32(R & 31);
        voffA[i] = (unsigned)(R * K + C) * 2u; voffB[i] = (unsigned)(Rb * K + C) * 2u; }
    const size_t kstep = (size_t)(BK * 2);
    const size_t hstep = (size_t)HALF * K * 2;
    const size_t tstep = 2 * hstep;
    const unsigned ldsw = (unsigned)wid * 1024u;
    const int aoff = lds_byte(wr * 64 + fr, fq * 8), boff = lds_byte(wc * 32 + fr, fq * 8);
#define PG8_SA(b, h) (((b) * 2 + (h)) * HTB)
#define PG8_SB(b, h) ((4 + (b) * 2 + (h)) * HTB)
#define PG8_STAGE(bufoff, gbase, voff) do { _Pragma("unroll") for (int _i = 0; _i < 2; ++_i) \
        __builtin_amdgcn_global_load_lds((const unsigned*)((const char*)(gbase) + (voff)[_i]), (LAS unsigned*)(lds + (bufoff) + ldsw + _i * 8192), 16, 0, 0); } while (0)
#define PG8_LDA(dst, b, h) do { _Pragma("unroll") for (int m = 0; m < 4; ++m) _Pragma("unroll") for (int k = 0; k < 2; ++k) dst[m][k] = *(const LAS bf16x8*)(lds + PG8_SA(b, h) + aoff + m * 2048 + k * 1024); } while (0)
#define PG8_LDB(dst, b, h) do { _Pragma("unroll") for (int n = 0; n < 2; ++n) _Pragma("unroll") for (int k = 0; k < 2; ++k) dst[n][k] = *(const LAS bf16x8*)(lds + PG8_SB(b, h) + boff + n * 2048 + k * 1024); } while (0)
#define PG8_MMA(ai, bj, At, Bt) do { __builtin_amdgcn_s_setprio(1); _Pragma("unroll") for (int m = 0; m < 4; ++m) _Pragma("unroll") for (int n = 0; n < 2; ++n) _Pragma("unroll") for (int k = 0; k < 2; ++k) \
        acc[ai][bj][m][n] = __builtin_amdgcn_mfma_f32_16x16x32_bf16(Bt[n][k], At[m][k], acc[ai][bj][m][n], 0, 0, 0); __builtin_amdgcn_s_setprio(0); } while (0)
#define PG8_WAIT_V(n) asm volatile("s_waitcnt vmcnt(" #n ")" ::: "memory")
#define PG8_WAIT_L(n) asm volatile("s_waitcnt lgkmcnt(" #n ")" ::: "memory")
#define PG8_BAR __builtin_amdgcn_s_barrier()
#define PG8_SCHED __builtin_amdgcn_sched_barrier(0)
    Unit cur, nxt; int ui = 0;
    if (!S.next(0, cur)) return;
    f32x4 acc[2][2][4][2];
#pragma unroll
    for (int a = 0; a < 2; ++a)
#pragma unroll
        for (int b = 0; b < 2; ++b)
#pragma unroll
            for (int m = 0; m < 4; ++m)
#pragma unroll
                for (int n = 0; n < 2; ++n) acc[a][b][m][n] = (f32x4){0.f, 0.f, 0.f, 0.f};
    bf16x8 At[4][2], B0[2][2], B1[2][2];
    const char* cA = (const char*)g.A + (size_t)cur.z * g.zA + (size_t)cur.pm * tstep; const char* cB = (const char*)g.Bt + (size_t)cur.z * g.zB + (size_t)cur.pn * tstep;
    PG8_STAGE(PG8_SB(0, 0), cB, voffB); PG8_STAGE(PG8_SB(0, 1), cB + hstep, voffB); PG8_STAGE(PG8_SA(0, 0), cA, voffA); PG8_STAGE(PG8_SA(0, 1), cA + hstep, voffA);
    if (wr == 1) PG8_BAR;
    PG8_WAIT_V(2); PG8_BAR;
    PG8_STAGE(PG8_SB(1, 0), cB + kstep, voffB); PG8_STAGE(PG8_SA(1, 0), cA + kstep, voffA); PG8_STAGE(PG8_SB(1, 1), cB + hstep + kstep, voffB);
    PG8_WAIT_V(6); PG8_BAR;
    for (;;) {
        const bool has_next = S.next(ui + 1, nxt);
        const char* nA = has_next ? (const char*)g.A + (size_t)nxt.z * g.zA + (size_t)nxt.pm * tstep : cA; const char* nB = has_next ? (const char*)g.Bt + (size_t)nxt.z * g.zB + (size_t)nxt.pn * tstep : cB;
        for (int t = 0; t < nt; t += 2) {
            const bool last = (t == nt - 2);
            const char* a1 = cA + (size_t)(t + 1) * kstep;
            const char* a2 = last ? nA : cA + (size_t)(t + 2) * kstep; const char* b2 = last ? nB : cB + (size_t)(t + 2) * kstep;
            const char* a3 = a2 + kstep; const char* b3 = b2 + kstep;
            PG8_LDB(B0, 0, 0); PG8_LDB(B1, 0, 1); PG8_SCHED; PG8_LDA(At, 0, 0); PG8_STAGE(PG8_SA(1, 1), a1 + hstep, voffA);
            PG8_WAIT_V(8); PG8_WAIT_L(0); PG8_BAR; PG8_MMA(0, 0, At, B0); PG8_MMA(0, 1, At, B1); PG8_BAR; PG8_SCHED;
            PG8_LDA(At, 0, 1); PG8_STAGE(PG8_SB(0, 0), b2, voffB); PG8_STAGE(PG8_SB(0, 1), b2 + hstep, voffB); PG8_STAGE(PG8_SA(0, 0), a2, voffA);
            PG8_WAIT_V(8); PG8_WAIT_L(0); PG8_BAR; PG8_MMA(1, 0, At, B0); PG8_MMA(1, 1, At, B1); PG8_BAR; PG8_SCHED;
            PG8_LDB(B0, 1, 0); PG8_LDB(B1, 1, 1); PG8_SCHED; PG8_LDA(At, 1, 0); PG8_STAGE(PG8_SA(0, 1), a2 + hstep, voffA);
            PG8_WAIT_V(8); PG8_WAIT_L(0); PG8_BAR; PG8_MMA(0, 0, At, B0); PG8_MMA(0, 1, At, B1); PG8_BAR; PG8_SCHED;
            PG8_LDA(At, 1, 1); PG8_STAGE(PG8_SB(1, 0), b3, voffB); PG8_STAGE(PG8_SB(1, 1), b3 + hstep, voffB); PG8_STAGE(PG8_SA(1, 0), a3, voffA);
            PG8_WAIT_V(8); PG8_WAIT_L(0); PG8_BAR; PG8_MMA(1, 0, At, B0); PG8_MMA(1, 1, At, B1); PG8_BAR; PG8_SCHED;
        }
        if (wr == 0) PG8_BAR;
        E(acc, cur, wr, wc, fr, fq);
        if (!has_next) break;
#pragma unroll
        for (int a = 0; a < 2; ++a)
#pragma unroll
            for (int b = 0; b < 2; ++b)
#pragma unroll
                for (int m = 0; m < 4; ++m)
#pragma unroll
                    for (int n = 0; n < 2; ++n) acc[a][b][m][n] = (f32x4){0.f, 0.f, 0.f, 0.f};
        cur = nxt; cA = nA; cB = nB; ++ui;
        if (wr == 1) PG8_BAR;
    }
    PG8_WAIT_V(0);
    PG8_BAR;
#undef PG8_SA
#undef PG8_SB
#undef PG8_STAGE
#undef PG8_LDA
#undef PG8_LDB
#undef PG8_MMA
#undef PG8_WAIT_V
#undef PG8_WAIT_L
#undef PG8_BAR
#undef PG8_SCHED
}
}

#define EPI_LOOP_BEGIN \
    const int row0 = u.pm * 256 + wr * 64 + fr, col0 = u.pn * 256 + wc * 32 + 8 * fq; \
    _Pragma("unroll") for (int ai = 0; ai < 2; ++ai) _Pragma("unroll") for (int m = 0; m < 4; ++m) { const int row = row0 + ai * 128 + m * 16; \
        _Pragma("unroll") for (int bj = 0; bj < 2; ++bj) { const int col = col0 + bj * 128; const f32x4 _c0 = acc[ai][bj][m][0], _c1 = acc[ai][bj][m][1]; \
            float v[8] = {_c0[0], _c0[1], _c0[2], _c0[3], _c1[0], _c1[1], _c1[2], _c1[3]};
#define EPI_LOOP_END } }

struct EpiG1 {
    bf16_t* PROJ; float* AF; float* IGFG; const float* LBl;
    __device__ __forceinline__ void operator()(const f32x4 (&acc)[2][2][4][2], const pg8::Unit& u, int wr, int wc, int fr, int fq) const {
        const int pn = u.pn;
        int kind;
        if (pn < 4) kind = 3; else if (pn < 8) kind = 4; else if (pn < 48) kind = 0; else if (pn < 72) kind = 2; else kind = 5;
        EPI_LOOP_BEGIN
            if (kind == 1) {
#pragma unroll
                for (int i = 0; i < 8; ++i) v[i] = siluf_(v[i]);
            } else if (kind == 2) {
#pragma unroll
                for (int i = 0; i < 8; ++i) v[i] = sigmoidf_(v[i]);
            } else if (kind == 3) {
#pragma unroll
                for (int i = 0; i < 8; ++i) v[i] = siluf_(v[i]) * 0.08838834764831845f;
            } else if (kind == 4) {
                const int c = col - C_AF;
                const f32x4 l0 = *(const f32x4*)(LBl + c), l1 = *(const f32x4*)(LBl + c + 4);
                const float lb[8] = {l0[0], l0[1], l0[2], l0[3], l1[0], l1[1], l1[2], l1[3]};
                float f[8];
#pragma unroll
                for (int i = 0; i < 8; ++i) { const float s = sigmoidf_(v[i]); f[i] = logf(fmaxf(lb[i] + (1.0f - lb[i]) * s, 1e-12f)); v[i] = (1.0f - lb[i]) * (1.0f - s); }
                float* fp = AF + (size_t)row * 1024 + c;
                *(f32x4*)fp = (f32x4){f[0], f[1], f[2], f[3]}; *(f32x4*)(fp + 4) = (f32x4){f[4], f[5], f[6], f[7]};
            } else if (kind == 5) {
                if (col == C_IG) { float* fp = IGFG + (size_t)row * 8; *(f32x4*)fp = (f32x4){v[0], v[1], v[2], v[3]}; *(f32x4*)(fp + 4) = (f32x4){v[4], v[5], v[6], v[7]}; }
            }
            *(u32x4*)(PROJ + (size_t)row * NP + col) = pack8(v);
        EPI_LOOP_END
    }
};
struct EpiLR {
    bf16_t* CW; bf16_t* CA; const float* w0; const float* a0;
    __device__ __forceinline__ void operator()(const f32x4 (&acc)[2][2][4][2], const pg8::Unit& u, int wr, int wc, int fr, int fq) const {
        const bool isw = u.pn < 4;
        const float* pb = isw ? w0 : a0 - 1024;
        bf16_t* ob = isw ? CW : CA - 1024;
        EPI_LOOP_BEGIN
            const f32x4 p0 = *(const f32x4*)(pb + col), p1 = *(const f32x4*)(pb + col + 4);
            const float p[8] = {p0[0], p0[1], p0[2], p0[3], p1[0], p1[1], p1[2], p1[3]};
            float o[8];
#pragma unroll
            for (int i = 0; i < 8; ++i) { o[i] = sigmoidf_(p[i] + v[i]); if (isw) o[i] = -0.6065306597126334f * o[i]; }
            *(u32x4*)(ob + (size_t)row * 1024 + col) = pack8(o);
            __builtin_amdgcn_sched_barrier(0);
        EPI_LOOP_END
    }
};
struct EpiG2 {
    const bf16_t* PROJ; bf16_t* MERGED;
    __device__ __forceinline__ void operator()(const f32x4 (&acc)[2][2][4][2], const pg8::Unit& u, int wr, int wc, int fr, int fq) const {
        const int z = u.z;
        EPI_LOOP_BEGIN
            float g[8]; unpack8(*(const u32x4*)(PROJ + (size_t)row * NP + C_G + z * 2048 + col), g);
            bf16_t* mp = MERGED + (size_t)row * D + col;
            if (z == 0) {
#pragma unroll
                for (int i = 0; i < 8; ++i) v[i] *= g[i];
            } else {
                float mm[8]; unpack8(*(const u32x4*)mp, mm);
#pragma unroll
                for (int i = 0; i < 8; ++i) v[i] = mm[i] + v[i] * g[i];
            }
            *(u32x4*)mp = pack8(v);
        EPI_LOOP_END
    }
};
struct EpiG3 {
    float* H;
    __device__ __forceinline__ void operator()(const f32x4 (&acc)[2][2][4][2], const pg8::Unit& u, int wr, int wc, int fr, int fq) const {
        EPI_LOOP_BEGIN
            float* hp = H + (size_t)row * D + col;
            const f32x4 h0 = *(const f32x4*)hp, h1 = *(const f32x4*)(hp + 4);
            *(f32x4*)hp = (f32x4){h0[0] + v[0], h0[1] + v[1], h0[2] + v[2], h0[3] + v[3]};
            *(f32x4*)(hp + 4) = (f32x4){h1[0] + v[4], h1[1] + v[5], h1[2] + v[6], h1[3] + v[7]};
        EPI_LOOP_END
    }
};

__device__ __forceinline__ int win_dest_row(int c) {
    if (c < 7168) return c;
    if (c < 7176) return C_IG + (c - 7168);
    if (c < 11272) return c - 8;
    if (c < 11400) return C_WD + (c - 11272);
    return c - 136;
}
template <bool WIN>
__device__ __forceinline__ void transpose_item(const float* W, int K, int N, bf16_t* WT, LAS float* scr, int item, int lane) {
    const int nblk = (N + 31) / 32, kb = item / nblk, nb = item % nblk, k0 = 64 * kb, n0 = 32 * nb;
    const int nn = n0 + (lane & 31);
#pragma unroll 8
    for (int i = 0; i < 32; ++i) { const int kk = 2 * i + (lane >> 5); scr[kk * 33 + (lane & 31)] = (nn < N) ? W[(size_t)(k0 + kk) * N + nn] : 0.f; }
    LDS_WAIT();
    const int c = lane & 7;
#pragma unroll
    for (int j = 0; j < 4; ++j) { const int n = (lane >> 3) + 8 * j; const LAS float* s = scr + (8 * c) * 33 + n;
        u32x4 o; o.x = cvt_pk_bf16(s[0 * 33], s[1 * 33]); o.y = cvt_pk_bf16(s[2 * 33], s[3 * 33]); o.z = cvt_pk_bf16(s[4 * 33], s[5 * 33]); o.w = cvt_pk_bf16(s[6 * 33], s[7 * 33]);
        if (n0 + n < N) { const int dr = WIN ? win_dest_row(n0 + n) : (n0 + n); *(u32x4*)(WT + (size_t)dr * K + k0 + 8 * c) = o; } }
    LDS_WAIT();
}

template <bool WIN, bool ZF>
__device__ __forceinline__ void tr_item(const float* W, int N, bf16_t* WT, int ldt, int kcol0, int item, int lane) {
    const int nblk = (N + 63) / 64, kb = item / nblk, nb = item - kb * nblk, k0 = 64 * kb, n = 64 * nb + lane;
    if (n >= N) return;
    float x[64];
#pragma unroll
    for (int i = 0; i < 64; ++i) x[i] = W[(size_t)(k0 + i) * N + n];
    const int dr = WIN ? win_dest_row(n) : n;
    bf16_t* row = WT + (size_t)dr * ldt;
#pragma unroll
    for (int g = 0; g < 8; ++g) { u32x4 o; o.x = cvt_pk_bf16(x[8 * g], x[8 * g + 1]); o.y = cvt_pk_bf16(x[8 * g + 2], x[8 * g + 3]); o.z = cvt_pk_bf16(x[8 * g + 4], x[8 * g + 5]); o.w = cvt_pk_bf16(x[8 * g + 6], x[8 * g + 7]);
        *(u32x4*)(row + kcol0 + k0 + 8 * g) = o; }
    if (ZF) {
#pragma unroll
        for (int g = 0; g < 32; ++g) if (g * 8 < kcol0 || g * 8 >= kcol0 + 64) *(u32x4*)(row + 8 * g) = (u32x4){0u, 0u, 0u, 0u};
    }
}

__device__ __forceinline__ void rms_row(const float* src, float* Hrow, const float* g, bf16_t* xn, int lane) {
    f32x4 v[8]; float ss = 0.f;
#pragma unroll
    for (int j = 0; j < 8; ++j) { v[j] = *(const f32x4*)(src + 256 * j + 4 * lane); ss += (v[j][0] * v[j][0] + v[j][1] * v[j][1]) + (v[j][2] * v[j][2] + v[j][3] * v[j][3]); }
    if (Hrow) {
#pragma unroll
        for (int j = 0; j < 8; ++j) *(f32x4*)(Hrow + 256 * j + 4 * lane) = v[j];
    }
    const float rs = rsqrtf(wave_sum(ss) * (1.0f / D) + 1e-6f);
#pragma unroll
    for (int j = 0; j < 8; ++j) { const f32x4 gg = *(const f32x4*)(g + 256 * j + 4 * lane);
        u32x2 o; o.x = cvt_pk_bf16(v[j][0] * rs * gg[0], v[j][1] * rs * gg[1]); o.y = cvt_pk_bf16(v[j][2] * rs * gg[2], v[j][3] * rs * gg[3]);
        *(u32x2*)(xn + 256 * j + 4 * lane) = o; }
}

struct Args { const float* in[23]; float* out; unsigned char* ws; };

constexpr int TB = 32, NBLK = (T + TB - 1) / TB;
constexpr int ST_FLOATS = 13312;
constexpr int OB_OFF = 2 * ST_FLOATS;
constexpr int MB_OFF = OB_OFF + 2 * 1024;

constexpr int NCH = 129, NSTREAM = 32, ITEM_ELEMS = 129 * 128, NITEMS_LA = NSTREAM * NCH;
constexpr int L_QA = 0, L_KB = 17408, L_QC = 34816, L_VT = 52224, L_ST = 70656, L_PB = 105472, L_SC = 114688;
constexpr int LDQ = 136, LDT = 72;
struct LaCtx { const bf16_t* PROJ; const float* AF; const bf16_t* BQK; const float* IL; bf16_t* DSI; bf16_t* DS; float* DEC; float* BEND; float* MLOC; float* MPREV; bf16_t* ORAW; float* DEN; float* MST; };
__device__ __forceinline__ bf16_t f2bf(float x) { return (bf16_t)(cvt_pk_bf16(x, 0.f) & 0xffffu); }
__device__ __forceinline__ float bf1(bf16_t b) { return __uint_as_float(((unsigned)b) << 16); }

__device__ __forceinline__ void la_phaseA(LAS unsigned char* lds, const LaCtx& X, int item) {
    int tid = threadIdx.x; asm volatile("" : "+v"(tid));
    const int wave = tid >> 6, lane = tid & 63, seg = tid >> 7, ch = tid & 127, fr = lane & 15, fq = lane >> 4;
    const int s = item / NCH, c = item - s * NCH, t0 = c * 64, mode = s >> 4;
    LAS bf16_t* KT = (LAS bf16_t*)(lds + L_QA);
    LAS bf16_t* VT = (LAS bf16_t*)(lds + L_VT);
    LAS float* SC = (LAS float*)(lds + L_SC);
    bf16_t* dsb = X.DSI + (size_t)item * ITEM_ELEMS;
    float kf[16]; bf16_t vr[16];
    if (mode == 0) {
        const int b = s >> 3, h = s & 7; const size_t rowbase = (size_t)b * T;
        float cs[16]; float run = 0.f;
#pragma unroll
        for (int i = 0; i < 16; ++i) { const int tt = t0 + seg * 16 + i; const bool ok = tt < T; const size_t row = rowbase + (ok ? tt : 0);
            const float lf = ok ? X.AF[row * 1024 + h * 128 + ch] : 0.f; run += lf; cs[i] = run;
            kf[i] = ok ? bf1(X.PROJ[row * NP + C_AF + h * 128 + ch]) : 0.f; vr[i] = ok ? X.PROJ[row * NP + C_AI + h * 128 + ch] : (bf16_t)0; }
        SC[seg * 128 + ch] = run;
        LDS_BAR();
        float off = 0.f, tot = 0.f;
#pragma unroll
        for (int s2 = 0; s2 < 4; ++s2) { const float x = SC[s2 * 128 + ch]; if (s2 < seg) off += x; tot += x; }
#pragma unroll
        for (int i = 0; i < 16; ++i) kf[i] *= __expf(tot - (off + cs[i]));
        if (seg == 0) X.DEC[((size_t)s * NCH + c) * 128 + ch] = __expf(tot);
    } else {
        const int bhm = (s - 16) >> 1, vhalf = (s - 16) & 1, b = bhm >> 2, h = bhm & 3; const size_t rowbase = (size_t)b * T;
#pragma unroll
        for (int i = 0; i < 16; ++i) { const int tt = t0 + seg * 16 + i; const bool ok = tt < T; const size_t row = rowbase + (ok ? tt : 0);
            kf[i] = ok ? bf1(X.BQK[row * 1024 + 512 + h * 128 + ch]) : 0.f;
            vr[i] = ok ? X.PROJ[row * NP + C_BV + h * 256 + vhalf * 128 + ch] : (bf16_t)0; }
        if (wave == 0) {
            const int tt = t0 + lane; const bool ok = tt < T; const size_t row = rowbase + (ok ? tt : 0);
            const float lfv = ok ? X.IL[row * 8 + 4 + h] : 0.f, igv = ok ? X.IL[row * 8 + h] : -1e30f;
            float bcs = lfv;
#pragma unroll
            for (int o = 1; o < 64; o <<= 1) { const float x = __shfl_up(bcs, o); if (lane >= o) bcs += x; }
            const float g = ok ? igv - bcs : -1e30f;
            float gm = g;
#pragma unroll
            for (int o = 1; o < 64; o <<= 1) gm = fmaxf(gm, __shfl_xor(gm, o));
            const float bend = __shfl(bcs, 63);
            SC[1024 + lane] = __expf(g - gm);
            if (lane == 0 && vhalf == 0) { X.BEND[bhm * NCH + c] = bend; X.MLOC[bhm * NCH + c] = bend + gm; }
        }
        LDS_BAR();
        float pn = 0.f;
#pragma unroll
        for (int i = 0; i < 16; ++i) { kf[i] *= SC[1024 + seg * 16 + i]; pn += kf[i]; }
        SC[512 + seg * 128 + ch] = pn;
    }
    {
        u32x4 k0, k1, v0, v1;
        k0.x = cvt_pk_bf16(kf[0], kf[1]); k0.y = cvt_pk_bf16(kf[2], kf[3]); k0.z = cvt_pk_bf16(kf[4], kf[5]); k0.w = cvt_pk_bf16(kf[6], kf[7]);
        k1.x = cvt_pk_bf16(kf[8], kf[9]); k1.y = cvt_pk_bf16(kf[10], kf[11]); k1.z = cvt_pk_bf16(kf[12], kf[13]); k1.w = cvt_pk_bf16(kf[14], kf[15]);
        v0.x = vr[0] | ((unsigned)vr[1] << 16); v0.y = vr[2] | ((unsigned)vr[3] << 16); v0.z = vr[4] | ((unsigned)vr[5] << 16); v0.w = vr[6] | ((unsigned)vr[7] << 16);
        v1.x = vr[8] | ((unsigned)vr[9] << 16); v1.y = vr[10] | ((unsigned)vr[11] << 16); v1.z = vr[12] | ((unsigned)vr[13] << 16); v1.w = vr[14] | ((unsigned)vr[15] << 16);
        *(LAS u32x4*)(KT + ch * LDT + seg * 16) = k0; *(LAS u32x4*)(KT + ch * LDT + seg * 16 + 8) = k1;
        *(LAS u32x4*)(VT + ch * LDT + seg * 16) = v0; *(LAS u32x4*)(VT + ch * LDT + seg * 16 + 8) = v1;
    }
    LDS_BAR();
    if (mode == 1 && seg == 0) dsb[128 * 128 + ch] = f2bf((SC[512 + ch] + SC[640 + ch]) + (SC[768 + ch] + SC[896 + ch]));
    {
        const int v0 = wave * 16;
        bf16x8 bv[2];
#pragma unroll
        for (int k = 0; k < 2; ++k) bv[k] = *(const LAS bf16x8*)(VT + (v0 + fr) * LDT + k * 32 + fq * 8);
#pragma unroll
        for (int nb = 0; nb < 8; ++nb) { const int d0 = nb * 16; f32x4 acc = (f32x4){0.f, 0.f, 0.f, 0.f};
#pragma unroll
            for (int k = 0; k < 2; ++k) { const bf16x8 a = *(const LAS bf16x8*)(KT + (d0 + fr) * LDT + k * 32 + fq * 8); acc = __builtin_amdgcn_mfma_f32_16x16x32_bf16(a, bv[k], acc, 0, 0, 0); }
            u32x2 o; o.x = cvt_pk_bf16(acc[0], acc[1]); o.y = cvt_pk_bf16(acc[2], acc[3]);
            *(u32x2*)(dsb + (size_t)(v0 + fr) * 128 + d0 + fq * 4) = o; }
    }
    LDS_BAR();
}

__device__ __forceinline__ void la_scan(const LaCtx& X) {
    int tid = threadIdx.x; asm volatile("" : "+v"(tid));
    const int task = blockIdx.x * NTHREADS + tid;
    if (task >= NSTREAM * 2064) return;
    const int s = task / 2064, rem = task - s * 2064, row = rem >> 4, d8 = (rem & 15) * 8, mode = s >> 4;
    if (mode == 0 && row == 128) return;
    bf16_t* base = X.DS + (size_t)s * NCH * ITEM_ELEMS + row * 128 + d8;
    const bf16_t* ibase = X.DSI + (size_t)s * NCH * ITEM_ELEMS + row * 128 + d8;
    const float* decb = X.DEC + (size_t)(s & 15) * NCH * 128 + d8;
    const int bhm = (s & 15) >> 1; const bool wr_m = (mode == 1) && ((s & 1) == 0) && (rem == 0);
    const float* bendp = X.BEND + bhm * NCH; const float* mlocp = X.MLOC + bhm * NCH;
    float S[8];
#pragma unroll
    for (int i = 0; i < 8; ++i) S[i] = 0.f;
    float m = 0.f;
    u32x4 x[4], y[4]; f32x4 da[4], db[4], ea[4], eb[4]; float be[4], ml[4], be2[4], ml2[4];
#pragma unroll
    for (int j = 0; j < 4; ++j) { x[j] = *(const u32x4*)(ibase + (size_t)j * ITEM_ELEMS);
        if (mode == 0) { da[j] = *(const f32x4*)(decb + j * 128); db[j] = *(const f32x4*)(decb + j * 128 + 4); be[j] = 0.f; ml[j] = 0.f; }
        else { be[j] = bendp[j]; ml[j] = mlocp[j]; da[j] = (f32x4){0.f, 0.f, 0.f, 0.f}; db[j] = da[j]; } }
    for (int c0 = 0; c0 < NCH; c0 += 4) {
#pragma unroll
        for (int j = 0; j < 4; ++j) { const int cn = c0 + 4 + j;
            if (cn < NCH) { y[j] = *(const u32x4*)(ibase + (size_t)cn * ITEM_ELEMS);
                if (mode == 0) { ea[j] = *(const f32x4*)(decb + cn * 128); eb[j] = *(const f32x4*)(decb + cn * 128 + 4); be2[j] = 0.f; ml2[j] = 0.f; }
                else { be2[j] = bendp[cn]; ml2[j] = mlocp[cn]; ea[j] = (f32x4){0.f, 0.f, 0.f, 0.f}; eb[j] = ea[j]; } }
            else { y[j] = (u32x4){0u, 0u, 0u, 0u}; ea[j] = (f32x4){0.f, 0.f, 0.f, 0.f}; eb[j] = ea[j]; be2[j] = 0.f; ml2[j] = 0.f; } }
#pragma unroll
        for (int j = 0; j < 4; ++j) { const int c = c0 + j;
            if (c < NCH) {
                *(u32x4*)(base + (size_t)c * ITEM_ELEMS) = pack8(S);
                float xv[8]; unpack8(x[j], xv);
                if (mode == 0) {
#pragma unroll
                    for (int i = 0; i < 4; ++i) { S[i] = da[j][i] * S[i] + xv[i]; S[4 + i] = db[j][i] * S[4 + i] + xv[4 + i]; }
                } else {
                    const float mnew = fmaxf(be[j] + m, ml[j]); const float carry = __expf(be[j] + m - mnew), wl = __expf(ml[j] - mnew);
                    if (wr_m) X.MPREV[bhm * NCH + c] = m;
#pragma unroll
                    for (int i = 0; i < 8; ++i) S[i] = carry * S[i] + wl * xv[i];
                    m = mnew;
                }
            } }
#pragma unroll
        for (int j = 0; j < 4; ++j) { x[j] = y[j]; da[j] = ea[j]; db[j] = eb[j]; be[j] = be2[j]; ml[j] = ml2[j]; }
    }
}

__device__ __forceinline__ void la_phaseC(LAS unsigned char* lds, const LaCtx& X, int item) {
    int tid = threadIdx.x; asm volatile("" : "+v"(tid));
    const int wave = tid >> 6, lane = tid & 63, seg = tid >> 7, ch = tid & 127, fr = lane & 15, fq = lane >> 4;
    const int s = item / NCH, c = item - s * NCH, t0 = c * 64, mode = s >> 4;
    LAS bf16_t* QA = (LAS bf16_t*)(lds + L_QA); LAS bf16_t* KB = (LAS bf16_t*)(lds + L_KB); LAS bf16_t* QC = (LAS bf16_t*)(lds + L_QC);
    LAS bf16_t* VT = (LAS bf16_t*)(lds + L_VT); LAS bf16_t* ST = (LAS bf16_t*)(lds + L_ST); LAS bf16_t* PB = (LAS bf16_t*)(lds + L_PB);
    LAS float* SC = (LAS float*)(lds + L_SC);
    const bf16_t* dsb = X.DS + (size_t)item * ITEM_ELEMS;
#pragma unroll
    for (int j = 0; j < 4; ++j) { const int q = tid + 512 * j, row = q >> 4, cc = (q & 15) * 8; *(LAS u32x4*)(ST + row * LDQ + cc) = *(const u32x4*)(dsb + row * 128 + cc); }
    size_t rowbase; int colbase, hden = 0; bool wden = false;
    bf16_t vr[16];
    const int tg = tid >> 4, chb = (tid & 15) * 8;
    if (mode == 0) {
        const int b = s >> 3, h = s & 7; rowbase = (size_t)b * T; colbase = h * 128;
        float lfv[2][8]; u32x4 qraw[2], kraw[2];
#pragma unroll
        for (int j = 0; j < 2; ++j) { const int tt = t0 + 2 * tg + j; const bool ok = tt < T; const size_t row = rowbase + (ok ? tt : 0);
            const f32x4 a0 = *(const f32x4*)(X.AF + row * 1024 + h * 128 + chb), a1 = *(const f32x4*)(X.AF + row * 1024 + h * 128 + chb + 4);
            const u32x4 qq = *(const u32x4*)(X.PROJ + row * NP + C_AQ + h * 128 + chb), kk = *(const u32x4*)(X.PROJ + row * NP + C_AF + h * 128 + chb);
#pragma unroll
            for (int i = 0; i < 4; ++i) { lfv[j][i] = ok ? a0[i] : 0.f; lfv[j][4 + i] = ok ? a1[i] : 0.f; }
            qraw[j] = ok ? qq : (u32x4){0u, 0u, 0u, 0u}; kraw[j] = ok ? kk : (u32x4){0u, 0u, 0u, 0u}; }
#pragma unroll
        for (int i = 0; i < 16; ++i) { const int tt = t0 + seg * 16 + i; const bool ok = tt < T; const size_t row = rowbase + (ok ? tt : 0);
            vr[i] = ok ? X.PROJ[row * NP + C_AI + h * 128 + ch] : (bf16_t)0; }
        float incl[8], gsum[8];
#pragma unroll
        for (int i = 0; i < 8; ++i) { gsum[i] = lfv[0][i] + lfv[1][i]; float x = gsum[i];
            float y = __shfl_up(x, 16); if (lane >= 16) x += y;
            y = __shfl_up(x, 32); if (lane >= 32) x += y;
            incl[i] = x; }
        if (lane >= 48) {
#pragma unroll
            for (int i = 0; i < 8; ++i) SC[wave * 128 + chb + i] = incl[i];
        }
        LDS_BAR();
        float cg0[8], cg1[8], refv[8];
#pragma unroll
        for (int i = 0; i < 8; ++i) { float off = 0.f, ref = 0.f;
#pragma unroll
            for (int w = 0; w < 8; ++w) { const float x = SC[w * 128 + chb + i]; if (w < wave) off += x; if (w < 4) ref += x; }
            const float base = off + (incl[i] - gsum[i]);
            cg0[i] = base + lfv[0][i]; cg1[i] = base + gsum[i]; refv[i] = ref; }
#pragma unroll
        for (int j = 0; j < 2; ++j) { const int t = 2 * tg + j; float qf[8], kf[8], e1[8], e2[8], e3[8];
            unpack8(qraw[j], qf); unpack8(kraw[j], kf);
#pragma unroll
            for (int i = 0; i < 8; ++i) { const float cg = j ? cg1[i] : cg0[i]; e1[i] = qf[i] * __expf(cg - refv[i]); e2[i] = kf[i] * __expf(refv[i] - cg); e3[i] = qf[i] * __expf(cg); }
            *(LAS u32x4*)(QA + t * LDQ + chb) = pack8(e1); *(LAS u32x4*)(KB + t * LDQ + chb) = pack8(e2); *(LAS u32x4*)(QC + t * LDQ + chb) = pack8(e3); }
    } else {
        const int bhm = (s - 16) >> 1, vhalf = (s - 16) & 1, b = bhm >> 2, h = bhm & 3; rowbase = (size_t)b * T; colbase = 1024 + h * 256 + vhalf * 128; hden = h; wden = (vhalf == 0);
        u32x4 qraw[2];
#pragma unroll
        for (int j = 0; j < 2; ++j) { const int t = 2 * tg + j, tt = t0 + t; const bool ok = tt < T; const size_t row = rowbase + (ok ? tt : 0);
            const u32x4 qq = *(const u32x4*)(X.BQK + row * 1024 + h * 128 + chb), kk = *(const u32x4*)(X.BQK + row * 1024 + 512 + h * 128 + chb);
            qraw[j] = ok ? qq : (u32x4){0u, 0u, 0u, 0u};
            *(LAS u32x4*)(QA + t * LDQ + chb) = qraw[j]; *(LAS u32x4*)(KB + t * LDQ + chb) = ok ? kk : (u32x4){0u, 0u, 0u, 0u}; }
#pragma unroll
        for (int i = 0; i < 16; ++i) { const int tt = t0 + seg * 16 + i; const bool ok = tt < T; const size_t row = rowbase + (ok ? tt : 0);
            vr[i] = ok ? X.PROJ[row * NP + C_BV + h * 256 + vhalf * 128 + ch] : (bf16_t)0; }
        if (wave == 0) {
            const int tt = t0 + lane; const bool ok = tt < T; const size_t row = rowbase + (ok ? tt : 0);
            const float lfv = ok ? X.IL[row * 8 + 4 + h] : 0.f, igv = ok ? X.IL[row * 8 + h] : -1e30f;
            float bcs = lfv;
#pragma unroll
            for (int o = 1; o < 64; o <<= 1) { const float x = __shfl_up(bcs, o); if (lane >= o) bcs += x; }
            const float g = ok ? igv - bcs : -1e30f;
            float gp = g;
#pragma unroll
            for (int o = 1; o < 64; o <<= 1) { const float x = __shfl_up(gp, o); if (lane >= o) gp = fmaxf(gp, x); }
            const float mprev = X.MPREV[bhm * NCH + c];
            const float mt = fmaxf(bcs + mprev, bcs + gp);
            SC[1088 + lane] = g; SC[1152 + lane] = bcs - mt; SC[1216 + lane] = __expf(bcs + mprev - mt); SC[1280 + lane] = mt;
        }
        if (tid < 128) SC[1344 + tid] = bf1(dsb[128 * 128 + tid]);
        LDS_BAR();
#pragma unroll
        for (int j = 0; j < 2; ++j) { const int t = 2 * tg + j; float qf[8]; unpack8(qraw[j], qf); const float it = SC[1216 + t];
#pragma unroll
            for (int i = 0; i < 8; ++i) qf[i] *= it;
            *(LAS u32x4*)(QC + t * LDQ + chb) = pack8(qf); }
    }
    {
        u32x4 v0, v1;
        v0.x = vr[0] | ((unsigned)vr[1] << 16); v0.y = vr[2] | ((unsigned)vr[3] << 16); v0.z = vr[4] | ((unsigned)vr[5] << 16); v0.w = vr[6] | ((unsigned)vr[7] << 16);
        v1.x = vr[8] | ((unsigned)vr[9] << 16); v1.y = vr[10] | ((unsigned)vr[11] << 16); v1.z = vr[12] | ((unsigned)vr[13] << 16); v1.w = vr[14] | ((unsigned)vr[15] << 16);
        *(LAS u32x4*)(VT + ch * LDT + seg * 16) = v0; *(LAS u32x4*)(VT + ch * LDT + seg * 16 + 8) = v1;
    }
    LDS_BAR();
    const int t0b = (wave >> 1) * 16;
    {
        bf16x8 bq[4];
#pragma unroll
        for (int k = 0; k < 4; ++k) bq[k] = *(const LAS bf16x8*)(QA + (t0b + fr) * LDQ + k * 32 + fq * 8);
#pragma unroll
        for (int sbi = 0; sbi < 2; ++sbi) { const int s0 = ((wave & 1) * 2 + sbi) * 16;
            u32x2 o = (u32x2){0u, 0u};
            if (s0 <= t0b + 15) {
                f32x4 acc = (f32x4){0.f, 0.f, 0.f, 0.f};
#pragma unroll
                for (int k = 0; k < 4; ++k) { const bf16x8 a = *(const LAS bf16x8*)(KB + (s0 + fr) * LDQ + k * 32 + fq * 8); acc = __builtin_amdgcn_mfma_f32_16x16x32_bf16(a, bq[k], acc, 0, 0, 0); }
                const int t = t0b + fr; float p[4];
                float rt = 0.f; f32x4 ct = (f32x4){0.f, 0.f, 0.f, 0.f};
                if (mode == 1) { rt = SC[1152 + t]; ct = *(const LAS f32x4*)(SC + 1088 + s0 + fq * 4); }
#pragma unroll
                for (int j = 0; j < 4; ++j) { const int sidx = s0 + fq * 4 + j; float v = acc[j]; if (mode == 1) v *= __expf(rt + ct[j]); p[j] = (sidx <= t) ? v : 0.f; }
                o.x = cvt_pk_bf16(p[0], p[1]); o.y = cvt_pk_bf16(p[2], p[3]);
            }
            *(LAS u32x2*)(PB + (t0b + fr) * LDT + s0 + fq * 4) = o; }
    }
    LDS_BAR();
    {
        bf16x8 bp[2], bc[4];
#pragma unroll
        for (int k = 0; k < 2; ++k) bp[k] = *(const LAS bf16x8*)(PB + (t0b + fr) * LDT + k * 32 + fq * 8);
#pragma unroll
        for (int k = 0; k < 4; ++k) bc[k] = *(const LAS bf16x8*)(QC + (t0b + fr) * LDQ + k * 32 + fq * 8);
        const int tt = t0 + t0b + fr;
#pragma unroll
        for (int vbi = 0; vbi < 4; ++vbi) { const int v0 = ((wave & 1) * 4 + vbi) * 16; f32x4 acc = (f32x4){0.f, 0.f, 0.f, 0.f};
#pragma unroll
            for (int k = 0; k < 2; ++k) { const bf16x8 a = *(const LAS bf16x8*)(VT + (v0 + fr) * LDT + k * 32 + fq * 8); acc = __builtin_amdgcn_mfma_f32_16x16x32_bf16(a, bp[k], acc, 0, 0, 0); }
#pragma unroll
            for (int k = 0; k < 4; ++k) { const bf16x8 a = *(const LAS bf16x8*)(ST + (v0 + fr) * LDQ + k * 32 + fq * 8); acc = __builtin_amdgcn_mfma_f32_16x16x32_bf16(a, bc[k], acc, 0, 0, 0); }
            if (tt < T) { u32x2 o; o.x = cvt_pk_bf16(acc[0], acc[1]); o.y = cvt_pk_bf16(acc[2], acc[3]); *(u32x2*)(X.ORAW + (rowbase + tt) * 3072 + colbase + v0 + fq * 4) = o; } }
    }
    if (mode == 1 && wden && tid < 64) {
        const int t = tid; float sum = 0.f, qn = 0.f;
#pragma unroll
        for (int k = 0; k < 8; ++k) { float f8[8]; unpack8(*(const LAS u32x4*)(PB + t * LDT + k * 8), f8);
#pragma unroll
            for (int i = 0; i < 8; ++i) sum += f8[i]; }
#pragma unroll
        for (int k = 0; k < 16; ++k) { float f8[8]; unpack8(*(const LAS u32x4*)(QC + t * LDQ + k * 8), f8);
#pragma unroll
            for (int i = 0; i < 8; ++i) qn += f8[i] * SC[1344 + k * 8 + i]; }
        const int tt = t0 + t;
        if (tt < T) { X.DEN[(rowbase + tt) * 4 + hden] = sum + qn; X.MST[(rowbase + tt) * 4 + hden] = SC[1280 + t]; }
    }
    LDS_BAR();
}

constexpr int RW_ITEMS = 32 * NCH;
constexpr size_t RWI_P = 0, RWI_R = 8192, RWI_DEC = 16384, RWI_W = 16640, RWI_U = 24832, RWI_BYTES = 33024;
struct RwCtx { const bf16_t* CRKV; const bf16_t* CW; const bf16_t* CA; const float* kkp; const float* kap; unsigned char* RWI; bf16_t* SRW; bf16_t* ORAW; };
constexpr int RW_SCR = 114944;

struct RwTok { float r[8], kp[8], av[8], bv[8], v[8], cw[8], lw[8]; };
__device__ __forceinline__ void rw_prep(LAS float* SCR, const RwCtx& X, int b, int h, int t0, int tid, RwTok& K) {
    const int t = tid >> 3, dq = tid & 7, lane = tid & 63, wave = tid >> 6;
    const int tt = t0 + t; const bool ok = tt < T; const size_t row = (size_t)b * T + (ok ? tt : 0);
    const bf16_t* pr = X.CRKV + row * 3072 + h * 64 + dq * 8;
    float kr[8], aa[8];
    unpack8(*(const u32x4*)pr, K.r); unpack8(*(const u32x4*)(pr + 1024), kr); unpack8(*(const u32x4*)(pr + 2048), K.v);
    unpack8(*(const u32x4*)(X.CA + row * 1024 + h * 64 + dq * 8), aa); unpack8(*(const u32x4*)(X.CW + row * 1024 + h * 64 + dq * 8), K.lw);
    const f32x4 p0 = *(const f32x4*)(X.kkp + h * 64 + dq * 8), p1 = *(const f32x4*)(X.kkp + h * 64 + dq * 8 + 4);
    const f32x4 q0 = *(const f32x4*)(X.kap + h * 64 + dq * 8), q1 = *(const f32x4*)(X.kap + h * 64 + dq * 8 + 4);
    float kk[8]; float ss = 0.f;
#pragma unroll
    for (int i = 0; i < 8; ++i) { kk[i] = kr[i] * (i < 4 ? p0[i & 3] : p1[i & 3]); ss += kk[i] * kk[i]; }
    ss += __shfl_xor(ss, 1); ss += __shfl_xor(ss, 2); ss += __shfl_xor(ss, 4);
    const float inv = 1.0f / fmaxf(sqrtf(ss), 1e-12f);
#pragma unroll
    for (int i = 0; i < 8; ++i) { const float kn = kk[i] * inv, ka = (i < 4 ? q0[i & 3] : q1[i & 3]);
        K.av[i] = -kn; K.bv[i] = kn * aa[i]; K.kp[i] = kr[i] * (1.0f + (aa[i] - 1.0f) * ka);
        if (!ok) { K.av[i] = 0.f; K.bv[i] = 0.f; K.kp[i] = 0.f; K.r[i] = 0.f; K.v[i] = 0.f; K.lw[i] = 0.f; } }
#pragma unroll
    for (int i = 0; i < 8; ++i) { float x = K.lw[i];
#pragma unroll
        for (int o = 8; o < 64; o <<= 1) { const float y = __shfl_up(x, o); if (lane >= o) x += y; }
        K.cw[i] = x; }
    if ((lane >> 3) == 7) {
#pragma unroll
        for (int i = 0; i < 8; ++i) SCR[wave * 64 + dq * 8 + i] = K.cw[i];
    }
    LDS_BAR();
#pragma unroll
    for (int i = 0; i < 8; ++i) { float off = 0.f;
#pragma unroll
        for (int w = 0; w < 7; ++w) if (w < wave) off += SCR[w * 64 + dq * 8 + i];
        K.cw[i] += off; }
}
__device__ __forceinline__ void rw_refs(const LAS float* SCR, int dq, float (&ref)[8], float (&cend)[8]) {
#pragma unroll
    for (int i = 0; i < 8; ++i) { float a = 0.f, b = 0.f;
#pragma unroll
        for (int w = 0; w < 8; ++w) { const float x = SCR[w * 64 + dq * 8 + i]; if (w < 4) a += x; b += x; }
        ref[i] = a; cend[i] = a + (b - a); cend[i] = b; }
}
__device__ __forceinline__ u32x4 pack8v(const float (&f)[8]) { return pack8(f); }

__device__ __forceinline__ void rw_phaseA(LAS unsigned char* lds, const RwCtx& X, int item) {
    int tid = threadIdx.x; asm volatile("" : "+v"(tid));
    const int wave = tid >> 6, lane = tid & 63, fr = lane & 15, fq = lane >> 4, t = tid >> 3, dq = tid & 7;
    const int bh = item / NCH, c = item - bh * NCH, b = bh >> 4, h = bh & 15, t0 = c * 64;
    LAS bf16_t* AT = (LAS bf16_t*)(lds + 0); LAS bf16_t* BB = (LAS bf16_t*)(lds + 9216); LAS bf16_t* KB = (LAS bf16_t*)(lds + 18432);
    LAS bf16_t* BtT = (LAS bf16_t*)(lds + 27648); LAS bf16_t* KtT = (LAS bf16_t*)(lds + 36864); LAS bf16_t* VT = (LAS bf16_t*)(lds + 46080);
    LAS float* XS = (LAS float*)(lds + 55296);
    LAS float* LAB = (LAS float*)(lds + 88320);
    LAS bf16_t* LAK = (LAS bf16_t*)(lds + 105728);
    LAS float* SCR = (LAS float*)(lds + RW_SCR);
    LAS bf16_t* Wt = (LAS bf16_t*)(lds + 0); LAS bf16_t* Ut = (LAS bf16_t*)(lds + 8192);
    LAS bf16_t* WT = (LAS bf16_t*)(lds + 18432); LAS bf16_t* UT = (LAS bf16_t*)(lds + 105728);
    unsigned char* gi = X.RWI + (size_t)item * RWI_BYTES;
    {
        RwTok K; rw_prep(SCR, X, b, h, t0, tid, K);
        float e1[8], e2[8], e3[8], e4[8];
        float refv[8], cendv[8]; rw_refs(SCR, dq, refv, cendv);
#pragma unroll
        for (int i = 0; i < 8; ++i) { const float ref = refv[i], cend = cendv[i];
            const float as = K.av[i] * __expf(K.cw[i] - K.lw[i]);
            XS[t * 129 + dq * 8 + i] = as;
            e1[i] = K.av[i] * __expf(K.cw[i] - K.lw[i] - ref); const float eb = __expf(ref - K.cw[i]); e2[i] = K.bv[i] * eb; e3[i] = K.kp[i] * eb;
            const float et = __expf(cend - K.cw[i]); e4[i] = et;
            BtT[(dq * 8 + i) * 72 + t] = f2bf(K.bv[i] * et); KtT[(dq * 8 + i) * 72 + t] = f2bf(K.kp[i] * et); VT[(dq * 8 + i) * 72 + t] = f2bf(K.v[i]);
            if (t == 0) *(float*)(gi + RWI_DEC + (dq * 8 + i) * 4) = __expf(cend); }
        *(LAS u32x4*)(AT + t * 72 + dq * 8) = pack8(e1); *(LAS u32x4*)(BB + t * 72 + dq * 8) = pack8(e2); *(LAS u32x4*)(KB + t * 72 + dq * 8) = pack8(e3);
        (void)e4;
    }
    LDS_BAR();
    const int t0b = (wave >> 1) * 16;
    {
        bf16x8 fa[2];
#pragma unroll
        for (int k = 0; k < 2; ++k) fa[k] = *(const LAS bf16x8*)(AT + (t0b + fr) * 72 + k * 32 + fq * 8);
#pragma unroll
        for (int sbi = 0; sbi < 2; ++sbi) { const int s0 = ((wave & 1) * 2 + sbi) * 16;
            f32x4 acc = (f32x4){0.f, 0.f, 0.f, 0.f}, acc2 = acc;
            if (s0 <= t0b + 15) {
#pragma unroll
                for (int k = 0; k < 2; ++k) { const bf16x8 fb = *(const LAS bf16x8*)(BB + (s0 + fr) * 72 + k * 32 + fq * 8), fk = *(const LAS bf16x8*)(KB + (s0 + fr) * 72 + k * 32 + fq * 8);
                    acc = __builtin_amdgcn_mfma_f32_16x16x32_bf16(fa[k], fb, acc, 0, 0, 0);
                    acc2 = __builtin_amdgcn_mfma_f32_16x16x32_bf16(fk, fa[k], acc2, 0, 0, 0); }
            }
#pragma unroll
            for (int j = 0; j < 4; ++j) { const int tt = t0b + fq * 4 + j, sidx = s0 + fr; LAB[tt * 68 + sidx] = (sidx < tt) ? acc[j] : 0.f; }
            float p[4];
#pragma unroll
            for (int j = 0; j < 4; ++j) p[j] = (s0 + fq * 4 + j < t0b + fr) ? acc2[j] : 0.f;
            u32x2 o; o.x = cvt_pk_bf16(p[0], p[1]); o.y = cvt_pk_bf16(p[2], p[3]);
            *(LAS u32x2*)(LAK + (t0b + fr) * 72 + s0 + fq * 4) = o; }
    }
    LDS_BAR();
    {
        bf16x8 fl[2];
#pragma unroll
        for (int k = 0; k < 2; ++k) fl[k] = *(const LAS bf16x8*)(LAK + (t0b + fr) * 72 + k * 32 + fq * 8);
#pragma unroll
        for (int bi = 0; bi < 2; ++bi) { const int v0 = ((wave & 1) * 2 + bi) * 16; f32x4 acc = (f32x4){0.f, 0.f, 0.f, 0.f};
#pragma unroll
            for (int k = 0; k < 2; ++k) { const bf16x8 fv = *(const LAS bf16x8*)(VT + (v0 + fr) * 72 + k * 32 + fq * 8); acc = __builtin_amdgcn_mfma_f32_16x16x32_bf16(fl[k], fv, acc, 0, 0, 0); }
#pragma unroll
            for (int j = 0; j < 4; ++j) XS[(t0b + fq * 4 + j) * 129 + 64 + v0 + fr] = acc[j]; }
    }
    LDS_BAR();
    int tid_s = threadIdx.x; asm volatile("" : "+v"(tid_s));
    if (tid_s < 128) {
        float x[64];
        int zv = 0; asm volatile("" : "+v"(zv));
        const LAS float* LABv = LAB + zv;
#pragma unroll
        for (int i = 0; i < 64; ++i) x[i] = XS[i * 129 + tid_s];
#pragma unroll
        for (int tt = 1; tt < 64; ++tt) { float a = x[tt];
#pragma unroll
            for (int s4 = 0; s4 < (tt + 3) / 4; ++s4) { const f32x4 l4 = *(const LAS f32x4*)(LABv + tt * 68 + s4 * 4);
                a += l4[0] * x[s4 * 4]; if (s4 * 4 + 1 < tt) a += l4[1] * x[s4 * 4 + 1]; if (s4 * 4 + 2 < tt) a += l4[2] * x[s4 * 4 + 2]; if (s4 * 4 + 3 < tt) a += l4[3] * x[s4 * 4 + 3]; }
            x[tt] = a;
#ifdef SOLVER_SB
            __builtin_amdgcn_sched_barrier(0);
#endif
        }
        LAS bf16_t* rowT = (tid_s < 64) ? (WT + tid_s * 72) : (UT + (tid_s - 64) * 72);
        LAS bf16_t* colN = (tid_s < 64) ? (Wt + tid_s) : (Ut + (tid_s - 64));
#pragma unroll
        for (int g = 0; g < 8; ++g) { u32x4 o; o.x = cvt_pk_bf16(x[8 * g], x[8 * g + 1]); o.y = cvt_pk_bf16(x[8 * g + 2], x[8 * g + 3]); o.z = cvt_pk_bf16(x[8 * g + 4], x[8 * g + 5]); o.w = cvt_pk_bf16(x[8 * g + 6], x[8 * g + 7]);
            *(LAS u32x4*)(rowT + 8 * g) = o; }
#pragma unroll
        for (int i = 0; i < 64; ++i) colN[i * 64] = f2bf(x[i]);
    }
    LDS_BAR();
    {
        int tid = threadIdx.x; asm volatile("" : "+v"(tid));
        const int wave = tid >> 6, lane = tid & 63, fr = lane & 15, fq = lane >> 4;
        const int d0 = (wave >> 1) * 16;
        bf16x8 fb[2], fk2[2];
#pragma unroll
        for (int k = 0; k < 2; ++k) { fb[k] = *(const LAS bf16x8*)(BtT + (d0 + fr) * 72 + k * 32 + fq * 8); fk2[k] = *(const LAS bf16x8*)(KtT + (d0 + fr) * 72 + k * 32 + fq * 8); }
#pragma unroll
        for (int bi = 0; bi < 2; ++bi) { const int n0 = ((wave & 1) * 2 + bi) * 16; f32x4 accp = (f32x4){0.f, 0.f, 0.f, 0.f}; f32x4 accr = accp;
#pragma unroll
            for (int k = 0; k < 2; ++k) { const bf16x8 fw = *(const LAS bf16x8*)(WT + (n0 + fr) * 72 + k * 32 + fq * 8), fu = *(const LAS bf16x8*)(UT + (n0 + fr) * 72 + k * 32 + fq * 8), fv = *(const LAS bf16x8*)(VT + (n0 + fr) * 72 + k * 32 + fq * 8);
                accp = __builtin_amdgcn_mfma_f32_16x16x32_bf16(fw, fb[k], accp, 0, 0, 0);
                accr = __builtin_amdgcn_mfma_f32_16x16x32_bf16(fb[k], fu, accr, 0, 0, 0);
                accr = __builtin_amdgcn_mfma_f32_16x16x32_bf16(fk2[k], fv, accr, 0, 0, 0); }
            u32x2 op; op.x = cvt_pk_bf16(accp[0], accp[1]); op.y = cvt_pk_bf16(accp[2], accp[3]);
            *(u32x2*)(gi + RWI_P + ((size_t)(d0 + fr) * 64 + n0 + fq * 4) * 2) = op;
            u32x2 orr; orr.x = cvt_pk_bf16(accr[0], accr[1]); orr.y = cvt_pk_bf16(accr[2], accr[3]);
            *(u32x2*)(gi + RWI_R + ((size_t)((wave * 2 + bi) * 64 + lane)) * 8) = orr; }
#pragma unroll
        for (int j = 0; j < 2; ++j) { const int q = tid + 512 * j; *(u32x4*)(gi + RWI_W + (size_t)q * 16) = *(const LAS u32x4*)(lds + (size_t)q * 16); }
    }
    LDS_BAR();
}

__device__ __forceinline__ void rw_phaseB(LAS unsigned char* lds, const RwCtx& X, int bh) {
    int tid = threadIdx.x; asm volatile("" : "+v"(tid));
    const int wave = tid >> 6, lane = tid & 63, fr = lane & 15, fq = lane >> 4;
    const int d0 = (wave >> 1) * 16, vb0 = (wave & 1) * 2;
    f32x4 acc[2]; acc[0] = (f32x4){0.f, 0.f, 0.f, 0.f}; acc[1] = acc[0];
    const unsigned char* gi = X.RWI + (size_t)bh * NCH * RWI_BYTES;
    bf16x8 pa[4][2], pn[4][2]; u32x2 rf[4][2], rn[4][2]; f32x4 dc[4], dn[4];
#define RWB_LOAD(PA, RF, DC, cc) do { const unsigned char* g_ = gi + (size_t)(cc) * RWI_BYTES; \
        _Pragma("unroll") for (int k = 0; k < 2; ++k) PA[k] = *(const bf16x8*)(g_ + RWI_P + ((size_t)(d0 + fr) * 64 + k * 32 + fq * 8) * 2); \
        _Pragma("unroll") for (int bi = 0; bi < 2; ++bi) RF[bi] = *(const u32x2*)(g_ + RWI_R + ((size_t)((wave * 2 + bi) * 64 + lane)) * 8); \
        DC = *(const f32x4*)(g_ + RWI_DEC + (d0 + fq * 4) * 4); } while (0)
#pragma unroll
    for (int j = 0; j < 4; ++j) RWB_LOAD(pa[j], rf[j], dc[j], j);
    for (int c0 = 0; c0 < NCH; c0 += 4) {
#pragma unroll
        for (int j = 0; j < 4; ++j) { const int cn = c0 + 4 + j;
            if (cn < NCH) RWB_LOAD(pn[j], rn[j], dn[j], cn);
            else { pn[j][0] = pa[j][0]; pn[j][1] = pa[j][1]; rn[j][0] = rf[j][0]; rn[j][1] = rf[j][1]; dn[j] = dc[j]; } }
#pragma unroll
        for (int j = 0; j < 4; ++j) { const int c = c0 + j;
            if (c < NCH) {
                LAS bf16_t* STb = (LAS bf16_t*)(lds + (c & 1) * 9216);
                bf16_t* sg = X.SRW + ((size_t)bh * NCH + c) * 4096;
#pragma unroll
                for (int bi = 0; bi < 2; ++bi) { const int v0 = (vb0 + bi) * 16; u32x2 o; o.x = cvt_pk_bf16(acc[bi][0], acc[bi][1]); o.y = cvt_pk_bf16(acc[bi][2], acc[bi][3]);
                    *(LAS u32x2*)(STb + (v0 + fr) * 72 + d0 + fq * 4) = o; *(u32x2*)(sg + (v0 + fr) * 64 + d0 + fq * 4) = o; }
                LDS_BAR();
#pragma unroll
                for (int bi = 0; bi < 2; ++bi) { const int v0 = (vb0 + bi) * 16;
                    f32x4 n = (f32x4){dc[j][0] * acc[bi][0] + bflo(rf[j][bi].x), dc[j][1] * acc[bi][1] + bfhi(rf[j][bi].x), dc[j][2] * acc[bi][2] + bflo(rf[j][bi].y), dc[j][3] * acc[bi][3] + bfhi(rf[j][bi].y)};
#pragma unroll
                    for (int k = 0; k < 2; ++k) { const bf16x8 fs = *(const LAS bf16x8*)(STb + (v0 + fr) * 72 + k * 32 + fq * 8); n = __builtin_amdgcn_mfma_f32_16x16x32_bf16(pa[j][k], fs, n, 0, 0, 0); }
                    acc[bi] = n; }
            } }
#pragma unroll
        for (int j = 0; j < 4; ++j) { pa[j][0] = pn[j][0]; pa[j][1] = pn[j][1]; rf[j][0] = rn[j][0]; rf[j][1] = rn[j][1]; dc[j] = dn[j]; }
    }
#undef RWB_LOAD
    LDS_BAR();
}

__device__ __forceinline__ void rw_phaseC(LAS unsigned char* lds, const RwCtx& X, int item) {
    int tid = threadIdx.x; asm volatile("" : "+v"(tid));
    const int wave = tid >> 6, lane = tid & 63, fr = lane & 15, fq = lane >> 4, t = tid >> 3, dq = tid & 7;
    const int bh = item / NCH, c = item - bh * NCH, b = bh >> 4, h = bh & 15, t0 = c * 64;
    LAS bf16_t* RT = (LAS bf16_t*)(lds + 0); LAS bf16_t* BB = (LAS bf16_t*)(lds + 9216); LAS bf16_t* KB = (LAS bf16_t*)(lds + 18432);
    LAS bf16_t* RS = (LAS bf16_t*)(lds + 27648); LAS bf16_t* VT = (LAS bf16_t*)(lds + 36864); LAS bf16_t* ST = (LAS bf16_t*)(lds + 46080);
    LAS bf16_t* Wt = (LAS bf16_t*)(lds + 55296); LAS bf16_t* RB = (LAS bf16_t*)(lds + 64512); LAS bf16_t* RK = (LAS bf16_t*)(lds + 73728); LAS bf16_t* UT = (LAS bf16_t*)(lds + 82944);
    LAS float* SCR = (LAS float*)(lds + RW_SCR);
    const unsigned char* gi = X.RWI + (size_t)item * RWI_BYTES;
    const int t0b = (wave >> 1) * 16;
    float u0v[2][4];
    { const bf16_t* u0g = (const bf16_t*)(gi + RWI_U);
#pragma unroll
      for (int bi = 0; bi < 2; ++bi)
#pragma unroll
        for (int j = 0; j < 4; ++j) u0v[bi][j] = bf1(u0g[(t0b + fq * 4 + j) * 64 + ((wave & 1) * 2 + bi) * 16 + fr]); }
    {
        *(LAS u32x4*)(ST + t * 72 + dq * 8) = *(const u32x4*)(X.SRW + (size_t)item * 4096 + t * 64 + dq * 8);
        *(LAS u32x4*)(Wt + t * 72 + dq * 8) = *(const u32x4*)(gi + RWI_W + ((size_t)t * 64 + dq * 8) * 2);
    }
    {
        RwTok K; rw_prep(SCR, X, b, h, t0, tid, K);
        float e1[8], e2[8], e3[8], e4[8];
        float refv[8], cendv[8]; rw_refs(SCR, dq, refv, cendv); (void)cendv;
#pragma unroll
        for (int i = 0; i < 8; ++i) { const float ref = refv[i];
            e1[i] = K.r[i] * __expf(K.cw[i] - ref); const float eb = __expf(ref - K.cw[i]); e2[i] = K.bv[i] * eb; e3[i] = K.kp[i] * eb; e4[i] = K.r[i] * __expf(K.cw[i]);
            VT[(dq * 8 + i) * 72 + t] = f2bf(K.v[i]); }
        *(LAS u32x4*)(RT + t * 72 + dq * 8) = pack8(e1); *(LAS u32x4*)(BB + t * 72 + dq * 8) = pack8(e2); *(LAS u32x4*)(KB + t * 72 + dq * 8) = pack8(e3); *(LAS u32x4*)(RS + t * 72 + dq * 8) = pack8(e4);
    }
    LDS_BAR();
    {
        bf16x8 fa[2];
#pragma unroll
        for (int k = 0; k < 2; ++k) fa[k] = *(const LAS bf16x8*)(RT + (t0b + fr) * 72 + k * 32 + fq * 8);
#pragma unroll
        for (int sbi = 0; sbi < 2; ++sbi) { const int s0 = ((wave & 1) * 2 + sbi) * 16;
            f32x4 ab = (f32x4){0.f, 0.f, 0.f, 0.f}, ak = ab;
            if (s0 <= t0b + 15) {
#pragma unroll
                for (int k = 0; k < 2; ++k) { const bf16x8 fb = *(const LAS bf16x8*)(BB + (s0 + fr) * 72 + k * 32 + fq * 8), fk = *(const LAS bf16x8*)(KB + (s0 + fr) * 72 + k * 32 + fq * 8);
                    ab = __builtin_amdgcn_mfma_f32_16x16x32_bf16(fb, fa[k], ab, 0, 0, 0);
                    ak = __builtin_amdgcn_mfma_f32_16x16x32_bf16(fk, fa[k], ak, 0, 0, 0); }
            }
            float pb[4], pk[4];
#pragma unroll
            for (int j = 0; j < 4; ++j) { const bool m = (s0 + fq * 4 + j <= t0b + fr); pb[j] = m ? ab[j] : 0.f; pk[j] = m ? ak[j] : 0.f; }
            u32x2 o1, o2; o1.x = cvt_pk_bf16(pb[0], pb[1]); o1.y = cvt_pk_bf16(pb[2], pb[3]); o2.x = cvt_pk_bf16(pk[0], pk[1]); o2.y = cvt_pk_bf16(pk[2], pk[3]);
            *(LAS u32x2*)(RB + (t0b + fr) * 72 + s0 + fq * 4) = o1; *(LAS u32x2*)(RK + (t0b + fr) * 72 + s0 + fq * 4) = o2; }
        bf16x8 fw[2];
#pragma unroll
        for (int k = 0; k < 2; ++k) fw[k] = *(const LAS bf16x8*)(Wt + (t0b + fr) * 72 + k * 32 + fq * 8);
#pragma unroll
        for (int bi = 0; bi < 2; ++bi) { const int v0 = ((wave & 1) * 2 + bi) * 16; f32x4 acc;
#pragma unroll
            for (int j = 0; j < 4; ++j) acc[j] = u0v[bi][j];
#pragma unroll
            for (int k = 0; k < 2; ++k) { const bf16x8 fs = *(const LAS bf16x8*)(ST + (v0 + fr) * 72 + k * 32 + fq * 8); acc = __builtin_amdgcn_mfma_f32_16x16x32_bf16(fw[k], fs, acc, 0, 0, 0); }
            u32x2 o; o.x = cvt_pk_bf16(acc[0], acc[1]); o.y = cvt_pk_bf16(acc[2], acc[3]);
            *(LAS u32x2*)(UT + (v0 + fr) * 72 + t0b + fq * 4) = o; }
    }
    LDS_BAR();
    {
        bf16x8 f1[2], f2[2], f3[2];
#pragma unroll
        for (int k = 0; k < 2; ++k) { f1[k] = *(const LAS bf16x8*)(RS + (t0b + fr) * 72 + k * 32 + fq * 8); f2[k] = *(const LAS bf16x8*)(RB + (t0b + fr) * 72 + k * 32 + fq * 8); f3[k] = *(const LAS bf16x8*)(RK + (t0b + fr) * 72 + k * 32 + fq * 8); }
        const int tt = t0 + t0b + fr;
#pragma unroll
        for (int bi = 0; bi < 2; ++bi) { const int v0 = ((wave & 1) * 2 + bi) * 16; f32x4 acc = (f32x4){0.f, 0.f, 0.f, 0.f};
#pragma unroll
            for (int k = 0; k < 2; ++k) { const bf16x8 a1 = *(const LAS bf16x8*)(ST + (v0 + fr) * 72 + k * 32 + fq * 8), a2 = *(const LAS bf16x8*)(UT + (v0 + fr) * 72 + k * 32 + fq * 8), a3 = *(const LAS bf16x8*)(VT + (v0 + fr) * 72 + k * 32 + fq * 8);
                acc = __builtin_amdgcn_mfma_f32_16x16x32_bf16(a1, f1[k], acc, 0, 0, 0); acc = __builtin_amdgcn_mfma_f32_16x16x32_bf16(a2, f2[k], acc, 0, 0, 0); acc = __builtin_amdgcn_mfma_f32_16x16x32_bf16(a3, f3[k], acc, 0, 0, 0); }
            if (tt < T) { u32x2 o; o.x = cvt_pk_bf16(acc[0], acc[1]); o.y = cvt_pk_bf16(acc[2], acc[3]); *(u32x2*)(X.ORAW + ((size_t)b * T + tt) * 3072 + 2048 + h * 64 + v0 + fq * 4) = o; } }
    }
    LDS_BAR();
}

constexpr int MT = 16384;
template <int K>
__device__ __forceinline__ void skinny_partial(const bf16_t* A, const bf16_t* Bt, int c0, int wave, int fr, int fq, f32x4 (&acc)[2]) {
    constexpr int kw = K >> 3; const int k0 = wave * kw;
    acc[0] = (f32x4){0.f, 0.f, 0.f, 0.f}; acc[1] = acc[0];
#pragma unroll
    for (int k = 0; k < kw; k += 32) {
        const bf16x8 fb = *(const bf16x8*)(Bt + (size_t)(c0 + fr) * K + k0 + k + fq * 8);
        const bf16x8 a0 = *(const bf16x8*)(A + (size_t)fr * K + k0 + k + fq * 8), a1 = *(const bf16x8*)(A + (size_t)(16 + fr) * K + k0 + k + fq * 8);
        acc[0] = __builtin_amdgcn_mfma_f32_16x16x32_bf16(a0, fb, acc[0], 0, 0, 0);
        acc[1] = __builtin_amdgcn_mfma_f32_16x16x32_bf16(a1, fb, acc[1], 0, 0, 0);
    }
}
__device__ __forceinline__ f32x4 skinny_reduce(LAS float* red, const f32x4 (&acc)[2], int wave, int lane) {
    *(LAS f32x4*)(red + ((wave * 2 + 0) * 64 + lane) * 4) = acc[0]; *(LAS f32x4*)(red + ((wave * 2 + 1) * 64 + lane) * 4) = acc[1];
    __syncthreads();
    f32x4 s = (f32x4){0.f, 0.f, 0.f, 0.f};
    if (wave < 2) {
#pragma unroll
        for (int w = 0; w < 8; ++w) s += *(const LAS f32x4*)(red + ((w * 2 + wave) * 64 + lane) * 4);
    }
    __syncthreads();
    return s;
}
__device__ __forceinline__ void skinny_g2(LAS float* red, const bf16_t* Y, const bf16_t* WBRl, const bf16_t* PROJ, bf16_t* MERGED, int c0) {
    int tid = threadIdx.x; asm volatile("" : "+v"(tid));
    const int wave = tid >> 6, lane = tid & 63, fr = lane & 15, fq = lane >> 4;
    f32x4 tot = (f32x4){0.f, 0.f, 0.f, 0.f};
    for (int z = 0; z < 3; ++z) {
        f32x4 acc[2]; skinny_partial<1024>(Y + ((size_t)z * MP + MT) * 1024, WBRl + (size_t)z * D * 1024, c0, wave, fr, fq, acc);
        const f32x4 s = skinny_reduce(red, acc, wave, lane);
        if (wave < 2) {
#pragma unroll
            for (int j = 0; j < 4; ++j) { const int row = MT + wave * 16 + fq * 4 + j; tot[j] += s[j] * bf1(PROJ[(size_t)row * NP + C_G + z * 2048 + c0 + fr]); }
        }
    }
    if (wave < 2) {
#pragma unroll
        for (int j = 0; j < 4; ++j) { const int row = MT + wave * 16 + fq * 4 + j; MERGED[(size_t)row * D + c0 + fr] = f2bf(tot[j]); }
    }
}
__device__ __forceinline__ void skinny_g3(LAS float* red, const bf16_t* MERGED, const bf16_t* WOUTl, float* H, int c0) {
    int tid = threadIdx.x; asm volatile("" : "+v"(tid));
    const int wave = tid >> 6, lane = tid & 63, fr = lane & 15, fq = lane >> 4;
    f32x4 acc[2]; skinny_partial<D>(MERGED + (size_t)MT * D, WOUTl, c0, wave, fr, fq, acc);
    const f32x4 s = skinny_reduce(red, acc, wave, lane);
    if (wave < 2) {
#pragma unroll
        for (int j = 0; j < 4; ++j) { const int row = MT + wave * 16 + fq * 4 + j; H[(size_t)row * D + c0 + fr] += s[j]; }
    }
}

__global__ void __launch_bounds__(NTHREADS, 2) fwd_megakernel(Args args) {
    extern __shared__ __attribute__((aligned(16))) unsigned char lds_raw[];
    cg::grid_group grid = cg::this_grid();
    LAS unsigned char* lds = (LAS unsigned char*)lds_raw;
    LAS float* ldsf = (LAS float*)lds_raw;
    if (threadIdx.x == 0) { ((volatile LAS unsigned*)(lds + 131072))[0] = 0u; ((volatile LAS unsigned*)(lds + 131072))[1] = 0u; }
    __syncthreads();
    const XcdBarrier gbar = xcd_barrier_post((unsigned*)(args.ws + WS_BAR), (volatile LAS unsigned*)(lds + 131072));
    const int G = gridDim.x, NGW = G * NWAVES;
    const size_t GT = (size_t)G * NTHREADS;
#define PHASE_IDS int tid = threadIdx.x; asm volatile("" : "+v"(tid)); const int lane = tid & 63, wave = tid >> 6, gw = blockIdx.x * NWAVES + wave; const size_t gt = (size_t)blockIdx.x * NTHREADS + tid; (void)lane; (void)gw; (void)gt;
    unsigned char* ws = args.ws;
    const float* x = args.in[0]; const float* meta = args.in[1]; const float* norm_g = args.in[2]; const float* w_in = args.in[3];
    const float* lb_logits = args.in[4]; const float* hgrn_g = args.in[5]; const float* mconv = args.in[6]; const float* ig_b = args.in[7];
    const float* fg_b = args.in[8]; const float* mnorm_g = args.in[9]; const float* mu = args.in[10]; const float* w0 = args.in[11];
    const float* w_up = args.in[12]; const float* a0 = args.in[13]; const float* a_up = args.in[14]; const float* k_k = args.in[15];
    const float* k_a = args.in[16]; const float* r_k = args.in[17]; const float* ln_g = args.in[18]; const float* ln_b = args.in[19];
    const float* w_br = args.in[20]; const float* w_out = args.in[21]; const float* fin_g = args.in[22];
    bf16_t* WINT = (bf16_t*)(ws + WS_WINT); bf16_t* WBRT = (bf16_t*)(ws + WS_WBRT); bf16_t* WOUTT = (bf16_t*)(ws + WS_WOUTT); bf16_t* WLRT = (bf16_t*)(ws + WS_WLRT);
    float* LB = (float*)(ws + WS_LB); float* H = (float*)(ws + WS_H); bf16_t* XN = (bf16_t*)(ws + WS_XN); bf16_t* PROJ = (bf16_t*)(ws + WS_PROJ);
    float* AF = (float*)(ws + WS_AF); float* IGFG = (float*)(ws + WS_IGFG); bf16_t* BQK = (bf16_t*)(ws + WS_BQK); float* IL = (float*)(ws + WS_IL);
    bf16_t* CRKV = (bf16_t*)(ws + WS_CRKV); bf16_t* ALR = (bf16_t*)(ws + WS_ALR); bf16_t* CW = (bf16_t*)(ws + WS_CW); bf16_t* CA = (bf16_t*)(ws + WS_CA);
    bf16_t* ORAW = (bf16_t*)(ws + WS_ORAW); float* DEN = (float*)(ws + WS_DEN); float* MST = (float*)(ws + WS_MST); bf16_t* Y = (bf16_t*)(ws + WS_Y);
    float* MACC = (float*)(ws + WS_MACC); bf16_t* MERGED = (bf16_t*)(ws + WS_MERGED);

#ifndef NO_P0
    {
        PHASE_IDS
        constexpr int I_IN = 32 * 291, I_BR = 16 * 32, I_OUT = 32 * 32, I_LR = 16;
        constexpr int NITEMS = DEPTH * I_IN + DEPTH * 3 * I_BR + DEPTH * I_OUT + DEPTH * 2 * I_LR;
        for (int it = gw; it < NITEMS; it += NGW) {
            int r = it;
            if (r < DEPTH * I_IN) { const int l = r / I_IN; tr_item<true, false>(w_in + (size_t)l * D * NIN, NIN, WINT + (size_t)l * NP * D, D, 0, r % I_IN, lane); continue; }
            r -= DEPTH * I_IN;
            if (r < DEPTH * 3 * I_BR) { const int mi = r / I_BR; tr_item<false, false>(w_br + (size_t)mi * 1024 * D, D, WBRT + (size_t)mi * D * 1024, 1024, 0, r % I_BR, lane); continue; }
            r -= DEPTH * 3 * I_BR;
            if (r < DEPTH * I_OUT) { const int l = r / I_OUT; tr_item<false, false>(w_out + (size_t)l * D * D, D, WOUTT + (size_t)l * D * D, D, 0, r % I_OUT, lane); continue; }
            r -= DEPTH * I_OUT;
            { const int l = r / (2 * I_LR), q = r % (2 * I_LR);
              if (q < I_LR) tr_item<false, true>(w_up + (size_t)l * 64 * 1024, 1024, WLRT + (size_t)l * 2048 * 256, 256, 0, q, lane);
              else tr_item<false, true>(a_up + (size_t)l * 64 * 1024, 1024, WLRT + ((size_t)l * 2048 + 1024) * 256, 256, 64, q - I_LR, lane); }
        }
        for (size_t i = gt; i < (size_t)DEPTH * (NP - NIN) * D / 8; i += GT) { const size_t per = (size_t)(NP - NIN) * D / 8; const size_t l = i / per, o = i % per;
            *(u32x4*)(WINT + (l * NP + NIN) * D + o * 8) = (u32x4){0u, 0u, 0u, 0u}; }
        for (size_t i = gt; i < 1024; i += GT) { float e[4], mx = -1e30f, s = 0.f;
#pragma unroll
            for (int l = 0; l < 4; ++l) { e[l] = lb_logits[l * 1024 + i]; mx = fmaxf(mx, e[l]); }
#pragma unroll
            for (int l = 0; l < 4; ++l) { e[l] = expf(e[l] - mx); s += e[l]; }
            const float p1 = e[1] / s, p2 = e[2] / s, p3 = e[3] / s;
            LB[i] = 0.f; LB[1024 + i] = p1; LB[2048 + i] = p1 + p2; LB[3072 + i] = p1 + p2 + p3; }
        for (int r = gw; r < M; r += NGW) { const int b = r / T, t = r - b * T;
            const float* src = (t < NMETA) ? meta + (size_t)t * D : x + ((size_t)b * SEQ + (t - NMETA)) * D;
            rms_row(src, H + (size_t)r * D, norm_g, XN + (size_t)r * D, lane); }
        for (size_t i = gt; i < (size_t)(MP - M) * D / 8; i += GT) { *(u32x4*)(XN + (size_t)M * D + i * 8) = (u32x4){0u, 0u, 0u, 0u}; *(u32x4*)(MERGED + (size_t)M * D + i * 8) = (u32x4){0u, 0u, 0u, 0u}; }
        for (size_t i = gt; i < (size_t)(MP - M) * 256 / 8; i += GT) *(u32x4*)(ALR + (size_t)M * 256 + i * 8) = (u32x4){0u, 0u, 0u, 0u};
        for (size_t i = gt; i < (size_t)3 * (MP - M) * 1024 / 8; i += GT) { const size_t per = (size_t)(MP - M) * 1024 / 8; const size_t z = i / per, o = i % per;
            *(u32x4*)(Y + (z * MP + M) * 1024 + o * 8) = (u32x4){0u, 0u, 0u, 0u}; }
    }
#endif
    __syncthreads();
    grid.sync();

    for (int l = 0; l < DEPTH; ++l) {
        if (l > 0) {
            PHASE_IDS
            for (int r = gw; r < M; r += NGW) rms_row(H + (size_t)r * D, nullptr, norm_g + (size_t)l * D, XN + (size_t)r * D, lane);
            xcd_barrier(gbar);
        }
        {
            pg8::Gemm g{XN, WINT + (size_t)l * NP * D, MP, NP, D, 0, 0};
            pg8::Order S; S.init(MP, NP, 1, G, (int)blockIdx.x);
            EpiG1 E{PROJ, AF, IGFG, LB + l * 1024};
#ifndef NO_G1
            pg8::gemm_phase<EpiG1>(lds, g, S, E);
#endif
        }
        xcd_barrier(gbar);
#ifndef NO_R1
        { PHASE_IDS
#pragma unroll 2
        for (int r = gw; r < M; r += NGW) {
            const int b = r / T, t = r - b * T;
            const bf16_t* pr = PROJ + (size_t)r * NP;
#pragma unroll
            for (int it = 0; it < 2; ++it) {
                const int c8 = (it * 64 + lane) * 8;
                float o[8];
#pragma unroll
                for (int i = 0; i < 8; ++i) o[i] = 0.f;
#pragma unroll
                for (int j = 0; j < 4; ++j) {
                    if (t - 3 + j >= 0) {
                        float xv[8]; unpack8(*(const u32x4*)(pr - (size_t)(3 - j) * NP + C_BQ + c8), xv);
                        const float* wp = mconv + ((size_t)l * 4 + j) * 1024 + c8;
                        const f32x4 w0v = *(const f32x4*)wp, w1v = *(const f32x4*)(wp + 4);
#pragma unroll
                        for (int i = 0; i < 4; ++i) { o[i] += w0v[i] * xv[i]; o[4 + i] += w1v[i] * xv[4 + i]; }
                    }
                }
                const float sc = (c8 < 512) ? 0.08838834764831845f : 1.0f;
#pragma unroll
                for (int i = 0; i < 8; ++i) o[i] = siluf_(o[i]) * sc;
                *(u32x4*)(BQK + (size_t)r * 1024 + c8) = pack8(o);
            }
            if (lane < 8) {
                const float raw = IGFG[(size_t)r * 8 + lane];
                float o;
                if (lane < 4) o = raw + ig_b[l * 4 + lane];
                else { const float z = raw + fg_b[l * 4 + (lane - 4)]; o = fminf(z, 0.f) - __logf(1.0f + __expf(-fabsf(z))); }
                IL[(size_t)r * 8 + lane] = o;
            }
#pragma unroll
            for (int it = 0; it < 6; ++it) {
                const int c8 = (it * 64 + lane) * 8;
                float cur[8], prv[8], o[8];
                unpack8(*(const u32x4*)(pr + C_CR + c8), cur);
                if (t > 0) unpack8(*(const u32x4*)(pr - NP + C_CR + c8), prv);
                else {
#pragma unroll
                    for (int i = 0; i < 8; ++i) prv[i] = 0.f;
                }
                const float* mp = mu + (size_t)l * 3200 + c8;
                const f32x4 m0 = *(const f32x4*)mp, m1 = *(const f32x4*)(mp + 4);
#pragma unroll
                for (int i = 0; i < 4; ++i) { o[i] = cur[i] + (prv[i] - cur[i]) * m0[i]; o[4 + i] = cur[4 + i] + (prv[4 + i] - cur[4 + i]) * m1[i]; }
                *(u32x4*)(CRKV + (size_t)r * 3072 + c8) = pack8(o);
            }
            if (lane < 16) {
                const int c8 = lane * 8;
                float cur[8], prv[8], o[8];
                unpack8(*(const u32x4*)(pr + C_WD + c8), cur);
                if (t > 0) unpack8(*(const u32x4*)(pr - NP + C_WD + c8), prv);
                else {
#pragma unroll
                    for (int i = 0; i < 8; ++i) prv[i] = 0.f;
                }
                const float* mp = mu + (size_t)l * 3200 + 3072 + c8;
                const f32x4 m0 = *(const f32x4*)mp, m1 = *(const f32x4*)(mp + 4);
#pragma unroll
                for (int i = 0; i < 4; ++i) { o[i] = cur[i] + (prv[i] - cur[i]) * m0[i]; o[4 + i] = cur[4 + i] + (prv[4 + i] - cur[4 + i]) * m1[i]; }
                if (lane < 8) {
#pragma unroll
                    for (int i = 0; i < 8; ++i) o[i] = tanhf(o[i]);
                }
                *(u32x4*)(ALR + (size_t)r * 256 + c8) = pack8(o);
            } else if (lane < 32) {
                *(u32x4*)(ALR + (size_t)r * 256 + lane * 8) = (u32x4){0u, 0u, 0u, 0u};
            }
        } }
#endif
        xcd_barrier(gbar);
        {
            pg8::Gemm g{ALR, WLRT + (size_t)l * 2048 * 256, MP, 2048, 256, 0, 0};
            pg8::Order S; S.init(MP, 2048, 1, G, (int)blockIdx.x);
            EpiLR E{CW, CA, w0 + (size_t)l * 1024, a0 + (size_t)l * 1024};
#ifndef NO_G1B
            pg8::gemm_phase<EpiLR>(lds, g, S, E);
#endif
        }
        xcd_barrier(gbar);
        const LaCtx X{PROJ, AF, BQK, IL, (bf16_t*)(ws + WS_DSI), (bf16_t*)(ws + WS_DS), (float*)(ws + WS_DEC), (float*)(ws + WS_BEND), (float*)(ws + WS_MLOC), (float*)(ws + WS_MPREV), ORAW, DEN, MST};
        const RwCtx RX{CRKV, CW, CA, k_k + (size_t)l * 1024, k_a + (size_t)l * 1024, ws + WS_RWI, (bf16_t*)(ws + WS_SRW), ORAW};
#ifndef NO_RWA
        for (int it = (int)blockIdx.x; it < RW_ITEMS; it += G) rw_phaseA(lds, RX, it);
#endif
        for (int it = ((int)blockIdx.x + G - 32) % G; it < NITEMS_LA; it += G) la_phaseA(lds, X, it);
        xcd_barrier(gbar);
        la_scan(X);
#ifndef NO_RWB
        if ((int)blockIdx.x >= G - 32) rw_phaseB(lds, RX, (int)blockIdx.x - (G - 32));
#endif
        xcd_barrier(gbar);
#ifndef NO_RWC
        for (int it = (int)blockIdx.x; it < RW_ITEMS; it += G) rw_phaseC(lds, RX, it);
#endif
        for (int it = ((int)blockIdx.x + G - 32) % G; it < NITEMS_LA; it += G) la_phaseC(lds, X, it);
        xcd_barrier(gbar);
#ifndef NO_NORM
        { PHASE_IDS
        for (int jb = gw; jb < MT + 3 * (M - MT); jb += NGW) {
            const int r = (jb < MT) ? jb : MT + (jb - MT) / 3;
            const int secmask = (jb < MT) ? 7 : (1 << ((jb - MT) % 3));
            const bf16_t* pr = PROJ + (size_t)r * NP;
            const int c0 = lane * 16;
            if (secmask & 1) {
                float o[16]; float ss = 0.f;
#pragma unroll
                for (int j = 0; j < 2; ++j) { float t8[8]; unpack8(*(const u32x4*)(ORAW + (size_t)r * 3072 + c0 + 8 * j), t8);
#pragma unroll
                    for (int i = 0; i < 8; ++i) o[8 * j + i] = t8[i]; }
#pragma unroll
                for (int i = 0; i < 16; ++i) ss += o[i] * o[i];
                ss += __shfl_xor(ss, 1); ss += __shfl_xor(ss, 2); ss += __shfl_xor(ss, 4);
                const float rs = rsqrtf(ss * (1.0f / 128.0f) + 1e-6f);
#pragma unroll
                for (int hh = 0; hh < 2; ++hh) {
                    float z8[8], y8[8]; unpack8(*(const u32x4*)(pr + C_AZ + c0 + 8 * hh), z8);
#pragma unroll
                    for (int i = 0; i < 8; ++i) z8[i] = siluf_(z8[i]);
                    const float* gp = hgrn_g + (size_t)l * 1024 + c0 + 8 * hh;
#pragma unroll
                    for (int i = 0; i < 8; ++i) y8[i] = o[8 * hh + i] * rs * gp[i] * z8[i];
                    *(u32x4*)(Y + (size_t)r * 1024 + c0 + 8 * hh) = pack8(y8);
                }
            }
            if (secmask & 2) {
                const int hd = lane >> 4;
                const float den = DEN[(size_t)r * 4 + hd], mm = MST[(size_t)r * 4 + hd];
                const float inv = 1.0f / fmaxf(fabsf(den), expf(-mm));
                float o[16]; float s1 = 0.f;
#pragma unroll
                for (int j = 0; j < 2; ++j) { float t8[8]; unpack8(*(const u32x4*)(ORAW + (size_t)r * 3072 + 1024 + c0 + 8 * j), t8);
#pragma unroll
                    for (int i = 0; i < 8; ++i) o[8 * j + i] = t8[i] * inv; }
#pragma unroll
                for (int i = 0; i < 16; ++i) s1 += o[i];
                s1 += __shfl_xor(s1, 1); s1 += __shfl_xor(s1, 2); s1 += __shfl_xor(s1, 4); s1 += __shfl_xor(s1, 8);
                const float mean = s1 * (1.0f / 256.0f);
                float s2 = 0.f;
#pragma unroll
                for (int i = 0; i < 16; ++i) { o[i] -= mean; s2 += o[i] * o[i]; }
                s2 += __shfl_xor(s2, 1); s2 += __shfl_xor(s2, 2); s2 += __shfl_xor(s2, 4); s2 += __shfl_xor(s2, 8);
                const float rs = rsqrtf(s2 * (1.0f / 256.0f) + 1e-6f);
#pragma unroll
                for (int hh = 0; hh < 2; ++hh) {
                    float og[8], z8[8], y8[8]; unpack8(*(const u32x4*)(pr + C_BO + c0 + 8 * hh), og); unpack8(*(const u32x4*)(pr + C_BZ + c0 + 8 * hh), z8);
#pragma unroll
                    for (int i = 0; i < 8; ++i) { og[i] = sigmoidf_(og[i]); z8[i] = siluf_(z8[i]); }
                    const float* gp = mnorm_g + (size_t)l * 1024 + c0 + 8 * hh;
#pragma unroll
                    for (int i = 0; i < 8; ++i) y8[i] = o[8 * hh + i] * rs * gp[i] * og[i] * z8[i];
                    *(u32x4*)(Y + ((size_t)MP + r) * 1024 + c0 + 8 * hh) = pack8(y8);
                }
            }
            if (secmask & 4) {
                float o[16]; float s1 = 0.f;
#pragma unroll
                for (int j = 0; j < 2; ++j) { float t8[8]; unpack8(*(const u32x4*)(ORAW + (size_t)r * 3072 + 2048 + c0 + 8 * j), t8);
#pragma unroll
                    for (int i = 0; i < 8; ++i) o[8 * j + i] = t8[i]; }
#pragma unroll
                for (int i = 0; i < 16; ++i) s1 += o[i];
                s1 += __shfl_xor(s1, 1); s1 += __shfl_xor(s1, 2);
                const float mean = s1 * (1.0f / 64.0f);
                float s2 = 0.f;
#pragma unroll
                for (int i = 0; i < 16; ++i) { o[i] -= mean; s2 += o[i] * o[i]; }
                s2 += __shfl_xor(s2, 1); s2 += __shfl_xor(s2, 2);
                const float rs = rsqrtf(s2 * (1.0f / 64.0f) + 64e-5f);
                const bf16_t* cr = CRKV + (size_t)r * 3072;
                float rr[16], kk[16], vv[16];
#pragma unroll
                for (int hh = 0; hh < 2; ++hh) {
                    float t8[8];
                    unpack8(*(const u32x4*)(cr + c0 + 8 * hh), t8);
#pragma unroll
                    for (int i = 0; i < 8; ++i) rr[8 * hh + i] = t8[i];
                    unpack8(*(const u32x4*)(cr + 1024 + c0 + 8 * hh), t8);
#pragma unroll
                    for (int i = 0; i < 8; ++i) kk[8 * hh + i] = t8[i];
                    unpack8(*(const u32x4*)(cr + 2048 + c0 + 8 * hh), t8);
#pragma unroll
                    for (int i = 0; i < 8; ++i) vv[8 * hh + i] = t8[i];
                }
                float bs = 0.f;
#pragma unroll
                for (int i = 0; i < 16; ++i) { const float aa = bf1(CA[(size_t)r * 1024 + c0 + i]); const float kp = kk[i] * (1.0f + (aa - 1.0f) * k_a[(size_t)l * 1024 + c0 + i]);
                    bs += rr[i] * kp * r_k[(size_t)l * 1024 + c0 + i]; }
                bs += __shfl_xor(bs, 1); bs += __shfl_xor(bs, 2);
#pragma unroll
                for (int hh = 0; hh < 2; ++hh) {
                    float z8[8], y8[8]; unpack8(*(const u32x4*)(pr + C_CZ + c0 + 8 * hh), z8);
#pragma unroll
                    for (int i = 0; i < 8; ++i) z8[i] = siluf_(z8[i]);
                    const float* gp = ln_g + (size_t)l * 1024 + c0 + 8 * hh; const float* bp = ln_b + (size_t)l * 1024 + c0 + 8 * hh;
#pragma unroll
                    for (int i = 0; i < 8; ++i) y8[i] = (o[8 * hh + i] * rs * gp[i] + bp[i] + bs * vv[8 * hh + i]) * z8[i];
                    *(u32x4*)(Y + ((size_t)2 * MP + r) * 1024 + c0 + 8 * hh) = pack8(y8);
                }
            }
        } }
#endif
        xcd_barrier(gbar);
        {
            pg8::Gemm g{Y, WBRT + (size_t)l * 3 * D * 1024, MT, D, 1024, (size_t)MP * 1024 * 2, (size_t)D * 1024 * 2};
            pg8::Order S; S.init(MT, D, 3, G, (int)blockIdx.x);
            EpiG2 E{PROJ, MERGED};
#ifndef NO_G2
            pg8::gemm_phase<EpiG2>(lds, g, S, E);
#endif
            for (int cb = (int)blockIdx.x; cb < D / 16; cb += G) skinny_g2(ldsf, Y, WBRT + (size_t)l * 3 * D * 1024, PROJ, MERGED, cb * 16);
        }
        xcd_barrier(gbar);
        {
            pg8::Gemm g{MERGED, WOUTT + (size_t)l * D * D, MT, D, D, 0, 0};
            pg8::Order S; S.init(MT, D, 1, G, (int)blockIdx.x);
            EpiG3 E{H};
#ifndef NO_G3
            pg8::gemm_phase<EpiG3>(lds, g, S, E);
#endif
            for (int cb = (int)blockIdx.x; cb < D / 16; cb += G) skinny_g3(ldsf, MERGED, WOUTT + (size_t)l * D * D, H, cb * 16);
        }
        xcd_barrier(gbar);
    }
    PHASE_IDS
    for (int r = gw; r < M; r += NGW) {
        const int b = r / T, t = r - b * T;
        if (t < NMETA) continue;
        const float* src = H + (size_t)r * D;
        float* dst = args.out + ((size_t)b * SEQ + (t - NMETA)) * D;
        f32x4 v[8]; float ss = 0.f;
#pragma unroll
        for (int j = 0; j < 8; ++j) { v[j] = *(const f32x4*)(src + 256 * j + 4 * lane); ss += (v[j][0] * v[j][0] + v[j][1] * v[j][1]) + (v[j][2] * v[j][2] + v[j][3] * v[j][3]); }
        const float rs = rsqrtf(wave_sum(ss) * (1.0f / D) + 1e-6f);
#pragma unroll
        for (int j = 0; j < 8; ++j) { const f32x4 gg = *(const f32x4*)(fin_g + 256 * j + 4 * lane);
            *(f32x4*)(dst + 256 * j + 4 * lane) = (f32x4){v[j][0] * rs * gg[0], v[j][1] * rs * gg[1], v[j][2] * rs * gg[2], v[j][3] * rs * gg[3]}; }
    }
}

extern "C" void kernel_launch(void* const* d_in, const int* in_sizes, int n_in, void* d_out, int out_size, void* d_ws, size_t ws_size, hipStream_t stream) {
    static int grid = 0;
    if (grid == 0) {
        if (n_in != 23 || ws_size < WS_END) { fprintf(stderr, "kernel_launch: unexpected n_in %d or workspace %zu < %zu\n", n_in, ws_size, (size_t)WS_END); grid = -1; return; }
        int dev = 0, cus = 0, per_cu = 0;
        (void)hipGetDevice(&dev);
        (void)hipDeviceGetAttribute(&cus, hipDeviceAttributeMultiprocessorCount, dev);
        (void)hipFuncSetAttribute((const void*)fwd_megakernel, hipFuncAttributeMaxDynamicSharedMemorySize, LDS_BYTES);
        (void)hipOccupancyMaxActiveBlocksPerMultiprocessor(&per_cu, (const void*)fwd_megakernel, NTHREADS, LDS_BYTES);
        if (per_cu < 1) per_cu = 1;
        grid = cus * per_cu;
        fprintf(stderr, "kernel_launch: grid %d (cus %d x %d), ws %zu need %zu\n", grid, cus, per_cu, ws_size, (size_t)WS_END);
    }
    if (grid < 0) return;
    Args a{};
    for (int i = 0; i < 23; ++i) a.in[i] = (const float*)d_in[i];
    a.out = (float*)d_out; a.ws = (unsigned char*)d_ws;
    (void)hipMemsetAsync((unsigned char*)d_ws + WS_BAR, 0, (size_t)XCD_BAR_WORDS * 4, stream);
    void* kargs[] = {&a};
    hipError_t e = hipLaunchCooperativeKernel((const void*)fwd_megakernel, dim3(grid), dim3(NTHREADS), kargs, LDS_BYTES, stream);
    if (e != hipSuccess) fprintf(stderr, "kernel_launch: cooperative launch failed: %s (grid %d)\n", hipGetErrorString(e), grid);
}
```

```cpp
#include <hip/hip_runtime.h>
#include <hip/hip_cooperative_groups.h>
#include <cstdio>
namespace cg = cooperative_groups;

#define LAS __attribute__((address_space(3)))
typedef unsigned short bf16_t;
typedef short bf16x8 __attribute__((ext_vector_type(8)));
typedef float f32x4 __attribute__((ext_vector_type(4)));
typedef float f32x2 __attribute__((ext_vector_type(2)));
typedef unsigned u32x4 __attribute__((ext_vector_type(4)));
typedef unsigned u32x2 __attribute__((ext_vector_type(2)));

constexpr int D = 2048, NB = 2, SEQ = 8192, DEPTH = 4, NMETA = 16;
constexpr int T = SEQ + NMETA;
constexpr int M = NB * T;
constexpr int MP = 16640;
constexpr int NIN = 18568, NP = 18688;
constexpr int NTHREADS = 512, NWAVES = 8;
constexpr int C_AQ = 0, C_AF = 1024, C_AI = 2048, C_AZ = 3072, C_BQ = 4096, C_BK = 4608, C_BV = 5120, C_BO = 6144, C_BZ = 7168;
constexpr int C_CR = 8192, C_CK = 9216, C_CV = 10240, C_CZ = 11264, C_G = 12288, C_WD = 18432, C_AD = 18496, C_IG = 18560;

constexpr size_t al256(size_t x) { return (x + 255) & ~(size_t)255; }
constexpr size_t WS_WINT = 0;
constexpr size_t WS_WBRT = WS_WINT + al256((size_t)DEPTH * NP * D * 2);
constexpr size_t WS_WOUTT = WS_WBRT + al256((size_t)DEPTH * 3 * D * 1024 * 2);
constexpr size_t WS_WLRT = WS_WOUTT + al256((size_t)DEPTH * D * D * 2);
constexpr size_t WS_LB = WS_WLRT + al256((size_t)DEPTH * 2048 * 256 * 2);
constexpr size_t WS_H = WS_LB + al256((size_t)DEPTH * 1024 * 4);
constexpr size_t WS_XN = WS_H + al256((size_t)MP * D * 4);
constexpr size_t WS_PROJ = WS_XN + al256((size_t)MP * D * 2);
constexpr size_t WS_AF = WS_PROJ + al256((size_t)MP * NP * 2);
constexpr size_t WS_IGFG = WS_AF + al256((size_t)MP * 1024 * 4);
constexpr size_t WS_BQK = WS_IGFG + al256((size_t)MP * 8 * 4);
constexpr size_t WS_IL = WS_BQK + al256((size_t)MP * 1024 * 2);
constexpr size_t WS_CRKV = WS_IL + al256((size_t)MP * 8 * 4);
constexpr size_t WS_ALR = WS_CRKV + al256((size_t)MP * 3072 * 2);
constexpr size_t WS_CW = WS_ALR + al256((size_t)MP * 256 * 2);
constexpr size_t WS_CA = WS_CW + al256((size_t)MP * 1024 * 4);
constexpr size_t WS_ORAW = WS_CA + al256((size_t)MP * 1024 * 4);
constexpr size_t WS_DEN = WS_ORAW + al256((size_t)MP * 3072 * 4);
constexpr size_t WS_MST = WS_DEN + al256((size_t)MP * 4 * 4);
constexpr size_t WS_Y = WS_MST + al256((size_t)MP * 4 * 4);
constexpr size_t WS_MACC = WS_Y + al256((size_t)3 * MP * 1024 * 2);
constexpr size_t WS_MERGED = WS_MACC + al256((size_t)MP * D * 4);
constexpr size_t WS_RWI = WS_MACC;
constexpr size_t WS_SRW = WS_MACC + (size_t)32 * 129 * 33024;
constexpr size_t WS_DS = WS_MERGED + al256((size_t)MP * D * 2);
constexpr size_t WS_DSI = WS_DS + al256((size_t)32 * 129 * 129 * 128 * 2);
constexpr size_t WS_DEC = WS_DSI + al256((size_t)32 * 129 * 129 * 128 * 2);
constexpr size_t WS_BEND = WS_DEC + al256((size_t)16 * 129 * 128 * 4);
constexpr size_t WS_MLOC = WS_BEND + al256((size_t)8 * 129 * 4);
constexpr size_t WS_MPREV = WS_MLOC + al256((size_t)8 * 129 * 4);
constexpr size_t WS_BAR = WS_MPREV + al256((size_t)8 * 129 * 4);
constexpr size_t WS_END = WS_BAR + al256((size_t)3456 * 4);

constexpr int LDS_BYTES = 131072 + 64;

typedef __bf16 bf16x2_t __attribute__((ext_vector_type(2)));
__device__ __forceinline__ unsigned cvt_pk_bf16(float lo, float hi) { const bf16x2_t r = __builtin_convertvector((f32x2){lo, hi}, bf16x2_t); return __builtin_bit_cast(unsigned, r); }
__device__ __forceinline__ float bflo(unsigned u) { return __uint_as_float(u << 16); }
__device__ __forceinline__ float bfhi(unsigned u) { return __uint_as_float(u & 0xffff0000u); }
__device__ __forceinline__ float sigmoidf_(float x) { return __builtin_amdgcn_rcpf(1.0f + __expf(-x)); }
__device__ __forceinline__ float siluf_(float x) { return x * __builtin_amdgcn_rcpf(1.0f + __expf(-x)); }
__device__ __forceinline__ void unpack8(const u32x4 u, float (&f)[8]) {
    f[0] = bflo(u.x); f[1] = bfhi(u.x); f[2] = bflo(u.y); f[3] = bfhi(u.y); f[4] = bflo(u.z); f[5] = bfhi(u.z); f[6] = bflo(u.w); f[7] = bfhi(u.w);
}
__device__ __forceinline__ u32x4 pack8(const float (&f)[8]) {
    u32x4 o; o.x = cvt_pk_bf16(f[0], f[1]); o.y = cvt_pk_bf16(f[2], f[3]); o.z = cvt_pk_bf16(f[4], f[5]); o.w = cvt_pk_bf16(f[6], f[7]); return o;
}
template <int CTRL> __device__ __forceinline__ float dpp_f(float v) { return __int_as_float(__builtin_amdgcn_update_dpp(0, __float_as_int(v), CTRL, 0xf, 0xf, false)); }
__device__ __forceinline__ float row_sum16(float v) {
    v += dpp_f<0x128>(v);
    v += dpp_f<0x124>(v);
    v += dpp_f<0x122>(v);
    v += dpp_f<0x121>(v);
    return v;
}
__device__ __forceinline__ float wave_sum(float v) {
#pragma unroll
    for (int o = 1; o < 64; o <<= 1) v += __shfl_xor(v, o);
    return v;
}
#define LDS_WAIT() asm volatile("s_waitcnt lgkmcnt(0)" ::: "memory")
#define LDS_BAR() do { asm volatile("s_waitcnt lgkmcnt(0)" ::: "memory"); __builtin_amdgcn_s_barrier(); asm volatile("" ::: "memory"); } while (0)

#define XB_TMO      128
#define XB_XCNT(j)  (256  + 64 * (j))
#define XB_XSUB(j)  (1280 + 64 * (j))
#define XB_XGEN(j)  (2304 + 64 * (j))
#define XB_TOP      3328
#define XB_TOPGEN   3392
#define XCD_BAR_WORDS 3456
#define XB_SPIN_CAP (1u << 20)
__device__ __forceinline__ unsigned xb_ld(unsigned* p)              { return __hip_atomic_load(p, __ATOMIC_RELAXED, __HIP_MEMORY_SCOPE_AGENT); }
__device__ __forceinline__ unsigned xb_add(unsigned* p, unsigned v) { return __hip_atomic_fetch_add(p, v, __ATOMIC_RELAXED, __HIP_MEMORY_SCOPE_AGENT); }
__device__ __forceinline__ unsigned xb_xcc_id() { return (unsigned)__builtin_amdgcn_s_getreg((3 << 11) | 20) & 0xFu; }
#define XB_SPIN(cond, bar) do { unsigned _sp = 0; while (cond) { __builtin_amdgcn_s_sleep(1); \
    if ((++_sp & 255u) == 0u) { if (xb_ld(&(bar)[XB_TMO])) break; if (_sp > XB_SPIN_CAP) { atomicAdd(&(bar)[XB_TMO], 1u); break; } } } } while (0)
struct XcdBarrier { unsigned* bar; unsigned x; volatile LAS unsigned* st; };
__device__ __forceinline__ XcdBarrier xcd_barrier_post(unsigned* bar, volatile LAS unsigned* st) {
    XcdBarrier b; b.bar = bar; b.x = xb_xcc_id(); b.st = st;
    if (threadIdx.x == 0) (void)xb_add(&bar[XB_XCNT(b.x)], 1u);
    return b;
}
__device__ __forceinline__ void xcd_barrier_complete(unsigned* bar, unsigned x, unsigned& nloc, unsigned& nx) {
    const unsigned G = gridDim.x * gridDim.y * gridDim.z;
    unsigned sum, cnt, mine, sp = 0u;
    for (;;) {
        sum = 0u; cnt = 0u; mine = 0u;
#pragma unroll
        for (unsigned j = 0; j < 16; ++j) { const unsigned c = xb_ld(&bar[XB_XCNT(j)]); sum += c; cnt += (c > 0u) ? 1u : 0u; mine = (j == x) ? c : mine; }
        if (sum == G) break;
        __builtin_amdgcn_s_sleep(1);
        if ((++sp & 255u) == 0u) { if (xb_ld(&bar[XB_TMO])) break; if (sp > XB_SPIN_CAP) { atomicAdd(&bar[XB_TMO], 1u); break; } }
    }
    nloc = mine > 0u ? mine : 1u; nx = cnt > 0u ? cnt : 1u;
}
__device__ __forceinline__ void xcd_barrier(const XcdBarrier& b) {
    asm volatile("s_waitcnt vmcnt(0)" ::: "memory");
    __syncthreads();
    if (threadIdx.x == 0) {
        unsigned* bar = b.bar;
        __builtin_amdgcn_s_waitcnt(0);
        unsigned nloc = b.st[0], nx = b.st[1];
        if (nloc == 0u) { xcd_barrier_complete(bar, b.x, nloc, nx); b.st[0] = nloc; b.st[1] = nx; }
        const unsigned old = xb_add(&bar[XB_XSUB(b.x)], 1u);
        const unsigned gen = old / nloc;
        if (old + 1u == (gen + 1u) * nloc) {
            __builtin_amdgcn_fence(__ATOMIC_RELEASE, "agent");
            asm volatile("s_waitcnt vmcnt(0)" ::: "memory");
            const unsigned og = xb_add(&bar[XB_TOP], 1u);
            const unsigned tg = og / nx;
            if (og + 1u == (tg + 1u) * nx) xb_add(&bar[XB_TOPGEN], 1u);
            else XB_SPIN(xb_ld(&bar[XB_TOPGEN]) == tg, bar);
            __builtin_amdgcn_fence(__ATOMIC_ACQUIRE, "agent");
            xb_add(&bar[XB_XGEN(b.x)], 1u);
            asm volatile("s_waitcnt vmcnt(0)" ::: "memory");
        } else {
            XB_SPIN(xb_ld(&bar[XB_XGEN(b.x)]) == gen, bar);
            __builtin_amdgcn_fence(__ATOMIC_ACQUIRE, "agent");
            asm volatile("s_waitcnt vmcnt(0)" ::: "memory");
        }
    }
    __syncthreads();
}

namespace pg8 {
constexpr int BM = 256, BK = 64, HALF = 128, HTB = HALF * BK * 2, STAGE_BYTES = 8 * HTB, NXCD = 8, WGM = 8;
__device__ __forceinline__ int lds_byte(int r, int c) { const int st = (r >> 4) * 2 + (c >> 5), rr = r & 15, cc = c & 31, ob = rr * 64 + cc * 2; return st * 1024 + (ob ^ (((ob >> 9) & 1) << 5)); }
__device__ __forceinline__ void stage_rc(int b, int& R, int& C) { const int st = b / 1024, sb = b % 1024, swz = sb ^ (((sb >> 9) & 1) << 5); R = (st >> 1) * 16 + swz / 64; C = (st & 1) * 32 + (swz % 64) / 2; }
__device__ __forceinline__ int perm32(int rho) { const int n = rho >> 4, i = rho & 15; return 8 * (i >> 2) + 4 * n + (i & 3); }

struct Unit { int pm, pn, z; };
struct Gemm { const bf16_t* A; const bf16_t* Bt; int M, N, K; size_t zA, zB; };

struct Order {
    int nM, nN, nwg, G, c, nz;
    __device__ void init(int M_, int N_, int nz_, int G_, int c_) { nM = M_ / BM; nN = N_ / BM; nwg = nM * nN; G = G_; c = c_; nz = nz_; }
    __device__ bool next(int i, Unit& u) const {
        const int ti = i / nz; u.z = i - ti * nz;
        const long L = (long)ti * G + c; if (L >= nwg) return false;
        int wgid = (int)L; { const int q = nwg / NXCD, r = nwg % NXCD, xcd = wgid % NXCD, off = wgid / NXCD; wgid = (xcd < r ? xcd * (q + 1) : r * (q + 1) + (xcd - r) * q) + off; }
        const int nig = WGM * nN, gid = wgid / nig, fm = gid * WGM, gsz = (nM - fm) < WGM ? (nM - fm) : WGM;
        u.pm = fm + ((wgid % nig) % gsz); u.pn = (wgid % nig) / gsz; return true;
    }
};

template <class Epi>
__device__ __forceinline__ void gemm_phase(LAS unsigned char* lds, const Gemm g, const Order& S, const Epi& E) {
    int tid = threadIdx.x; asm volatile("" : "+v"(tid));
    const int wid = __builtin_amdgcn_readfirstlane(tid >> 6), lane = tid & 63, wr = wid >> 2, wc = wid & 3, fr = lane & 15, fq = lane >> 4;
    int K = g.K; asm volatile("" : "+s"(K));
    const int nt = K / BK;
    unsigned voffA[2], voffB[2];
#pragma unroll
    for (int i = 0; i < 2; ++i) { int R, C; stage_rc(tid * 16 + i * 8192, R, C); const int Rb = (R & ~31) + perm32(R & 31);
        voffA[i] = (unsigned)(R * K + C) * 2u; voffB[i] = (unsigned)(Rb * K + C) * 2u; }
    const size_t kstep = (size_t)(BK * 2);
    const size_t hstep = (size_t)HALF * K * 2;
    const size_t tstep = 2 * hstep;
    const unsigned ldsw = (unsigned)wid * 1024u;
    const int aoff = lds_byte(wr * 64 + fr, fq * 8), boff = lds_byte(wc * 32 + fr, fq * 8);
#define PG8_SA(b, h) (((b) * 2 + (h)) * HTB)
#define PG8_SB(b, h) ((4 + (b) * 2 + (h)) * HTB)
#define PG8_STAGE(bufoff, gbase, voff) do { _Pragma("unroll") for (int _i = 0; _i < 2; ++_i) \
        __builtin_amdgcn_global_load_lds((const unsigned*)((const char*)(gbase) + (voff)[_i]), (LAS unsigned*)(lds + (bufoff) + ldsw + _i * 8192), 16, 0, 0); } while (0)
#define PG8_LDA(dst, b, h) do { _Pragma("unroll") for (int m = 0; m < 4; ++m) _Pragma("unroll") for (int k = 0; k < 2; ++k) dst[m][k] = *(const LAS bf16x8*)(lds + PG8_SA(b, h) + aoff + m * 2048 + k * 1024); } while (0)
#define PG8_LDB(dst, b, h) do { _Pragma("unroll") for (int n = 0; n < 2; ++n) _Pragma("unroll") for (int k = 0; k < 2; ++k) dst[n][k] = *(const LAS bf16x8*)(lds + PG8_SB(b, h) + boff + n * 2048 + k * 1024); } while (0)
#define PG8_MMA(ai, bj, At, Bt) do { __builtin_amdgcn_s_setprio(1); _Pragma("unroll") for (int m = 0; m < 4; ++m) _Pragma("unroll") for (int n = 0; n < 2; ++n) _Pragma("unroll") for (int k = 0; k < 2; ++k) \
        acc[ai][bj][m][n] = __builtin_amdgcn_mfma_f32_16x16x32_bf16(Bt[n][k], At[m][k], acc[ai][bj][m][n], 0, 0, 0); __builtin_amdgcn_s_setprio(0); } while (0)
#define PG8_WAIT_V(n) asm volatile("s_waitcnt vmcnt(" #n ")" ::: "memory")
#define PG8_WAIT_L(n) asm volatile("s_waitcnt lgkmcnt(" #n ")" ::: "memory")
#define PG8_BAR __builtin_amdgcn_s_barrier()
#define PG8_SCHED __builtin_amdgcn_sched_barrier(0)
    Unit cur, nxt; int ui = 0;
    if (!S.next(0, cur)) return;
    f32x4 acc[2][2][4][2];
#pragma unroll
    for (int a = 0; a < 2; ++a)
#pragma unroll
        for (int b = 0; b < 2; ++b)
#pragma unroll
            for (int m = 0; m < 4; ++m)
#pragma unroll
                for (int n = 0; n < 2; ++n) acc[a][b][m][n] = (f32x4){0.f, 0.f, 0.f, 0.f};
    bf16x8 At[4][2], B0[2][2], B1[2][2];
    const char* cA = (const char*)g.A + (size_t)cur.z * g.zA + (size_t)cur.pm * tstep; const char* cB = (const char*)g.Bt + (size_t)cur.z * g.zB + (size_t)cur.pn * tstep;
    PG8_STAGE(PG8_SB(0, 0), cB, voffB); PG8_STAGE(PG8_SB(0, 1), cB + hstep, voffB); PG8_STAGE(PG8_SA(0, 0), cA, voffA); PG8_STAGE(PG8_SA(0, 1), cA + hstep, voffA);
    if (wr == 1) PG8_BAR;
    PG8_WAIT_V(2); PG8_BAR;
    PG8_STAGE(PG8_SB(1, 0), cB + kstep, voffB); PG8_STAGE(PG8_SA(1, 0), cA + kstep, voffA); PG8_STAGE(PG8_SB(1, 1), cB + hstep + kstep, voffB);
    PG8_WAIT_V(6); PG8_BAR;
    for (;;) {
        const bool has_next = S.next(ui + 1, nxt);
        const char* nA = has_next ? (const char*)g.A + (size_t)nxt.z * g.zA + (size_t)nxt.pm * tstep : cA; const char* nB = has_next ? (const char*)g.Bt + (size_t)nxt.z * g.zB + (size_t)nxt.pn * tstep : cB;
        for (int t = 0; t < nt; t += 2) {
            const bool last = (t == nt - 2);
            const char* a1 = cA + (size_t)(t + 1) * kstep;
            const char* a2 = last ? nA : cA + (size_t)(t + 2) * kstep; const char* b2 = last ? nB : cB + (size_t)(t + 2) * kstep;
            const char* a3 = a2 + kstep; const char* b3 = b2 + kstep;
            PG8_LDB(B0, 0, 0); PG8_LDB(B1, 0, 1); PG8_SCHED; PG8_LDA(At, 0, 0); PG8_STAGE(PG8_SA(1, 1), a1 + hstep, voffA);
            PG8_WAIT_V(8); PG8_WAIT_L(0); PG8_BAR; PG8_MMA(0, 0, At, B0); PG8_MMA(0, 1, At, B1); PG8_BAR; PG8_SCHED;
            PG8_LDA(At, 0, 1); PG8_STAGE(PG8_SB(0, 0), b2, voffB); PG8_STAGE(PG8_SB(0, 1), b2 + hstep, voffB); PG8_STAGE(PG8_SA(0, 0), a2, voffA);
            PG8_WAIT_V(8); PG8_WAIT_L(0); PG8_BAR; PG8_MMA(1, 0, At, B0); PG8_MMA(1, 1, At, B1); PG8_BAR; PG8_SCHED;
            PG8_LDB(B0, 1, 0); PG8_LDB(B1, 1, 1); PG8_SCHED; PG8_LDA(At, 1, 0); PG8_STAGE(PG8_SA(0, 1), a2 + hstep, voffA);
            PG8_WAIT_V(8); PG8_WAIT_L(0); PG8_BAR; PG8_MMA(0, 0, At, B0); PG8_MMA(0, 1, At, B1); PG8_BAR; PG8_SCHED;
            PG8_LDA(At, 1, 1); PG8_STAGE(PG8_SB(1, 0), b3, voffB); PG8_STAGE(PG8_SB(1, 1), b3 + hstep, voffB); PG8_STAGE(PG8_SA(1, 0), a3, voffA);
            PG8_WAIT_V(8); PG8_WAIT_L(0); PG8_BAR; PG8_MMA(1, 0, At, B0); PG8_MMA(1, 1, At, B1); PG8_BAR; PG8_SCHED;
        }
        if (wr == 0) PG8_BAR;
        E(acc, cur, wr, wc, fr, fq);
        if (!has_next) break;
#pragma unroll
        for (int a = 0; a < 2; ++a)
#pragma unroll
            for (int b = 0; b < 2; ++b)
#pragma unroll
                for (int m = 0; m < 4; ++m)
#pragma unroll
                    for (int n = 0; n < 2; ++n) acc[a][b][m][n] = (f32x4){0.f, 0.f, 0.f, 0.f};
        cur = nxt; cA = nA; cB = nB; ++ui;
        if (wr == 1) PG8_BAR;
    }
    PG8_WAIT_V(0);
    PG8_BAR;
#undef PG8_SA
#undef PG8_SB
#undef PG8_STAGE
#undef PG8_LDA
#undef PG8_LDB
#undef PG8_MMA
#undef PG8_WAIT_V
#undef PG8_WAIT_L
#undef PG8_BAR
#undef PG8_SCHED
}
}

#define EPI_LOOP_BEGIN \
    const int row0 = u.pm * 256 + wr * 64 + fr, col0 = u.pn * 256 + wc * 32 + 8 * fq; \
    _Pragma("unroll") for (int ai = 0; ai < 2; ++ai) _Pragma("unroll") for (int m = 0; m < 4; ++m) { const int row = row0 + ai * 128 + m * 16; \
        _Pragma("unroll") for (int bj = 0; bj < 2; ++bj) { const int col = col0 + bj * 128; const f32x4 _c0 = acc[ai][bj][m][0], _c1 = acc[ai][bj][m][1]; \
            float v[8] = {_c0[0], _c0[1], _c0[2], _c0[3], _c1[0], _c1[1], _c1[2], _c1[3]};
#define EPI_LOOP_END } }

struct EpiG1 {
    bf16_t* PROJ; float* AF; float* IGFG; const float* LBl;
    __device__ __forceinline__ void operator()(const f32x4 (&acc)[2][2][4][2], const pg8::Unit& u, int wr, int wc, int fr, int fq) const {
        const int pn = u.pn;
        int kind;
        if (pn < 4) kind = 3; else if (pn < 8) kind = 4; else if (pn < 48) kind = 0; else if (pn < 72) kind = 2; else kind = 5;
        EPI_LOOP_BEGIN
            if (kind == 1) {
#pragma unroll
                for (int i = 0; i < 8; ++i) v[i] = siluf_(v[i]);
            } else if (kind == 2) {
#pragma unroll
                for (int i = 0; i < 8; ++i) v[i] = sigmoidf_(v[i]);
            } else if (kind == 3) {
#pragma unroll
                for (int i = 0; i < 8; ++i) v[i] = siluf_(v[i]) * 0.08838834764831845f;
            } else if (kind == 4) {
                const int c = col - C_AF;
                const f32x4 l0 = *(const f32x4*)(LBl + c), l1 = *(const f32x4*)(LBl + c + 4);
                const float lb[8] = {l0[0], l0[1], l0[2], l0[3], l1[0], l1[1], l1[2], l1[3]};
                float f[8];
#pragma unroll
                for (int i = 0; i < 8; ++i) { const float s = sigmoidf_(v[i]); f[i] = logf(fmaxf(lb[i] + (1.0f - lb[i]) * s, 1e-12f)); v[i] = (1.0f - lb[i]) * (1.0f - s); }
                float* fp = AF + (size_t)row * 1024 + c;
                *(f32x4*)fp = (f32x4){f[0], f[1], f[2], f[3]}; *(f32x4*)(fp + 4) = (f32x4){f[4], f[5], f[6], f[7]};
            } else if (kind == 5) {
                if (col == C_IG) { float* fp = IGFG + (size_t)row * 8; *(f32x4*)fp = (f32x4){v[0], v[1], v[2], v[3]}; *(f32x4*)(fp + 4) = (f32x4){v[4], v[5], v[6], v[7]}; }
            }
            *(u32x4*)(PROJ + (size_t)row * NP + col) = pack8(v);
        EPI_LOOP_END
    }
};
struct EpiLR {
    bf16_t* CW; bf16_t* CA; const float* w0; const float* a0;
    __device__ __forceinline__ void operator()(const f32x4 (&acc)[2][2][4][2], const pg8::Unit& u, int wr, int wc, int fr, int fq) const {
        const bool isw = u.pn < 4;
        const float* pb = isw ? w0 : a0 - 1024;
        bf16_t* ob = isw ? CW : CA - 1024;
        EPI_LOOP_BEGIN
            const f32x4 p0 = *(const f32x4*)(pb + col), p1 = *(const f32x4*)(pb + col + 4);
            const float p[8] = {p0[0], p0[1], p0[2], p0[3], p1[0], p1[1], p1[2], p1[3]};
            float o[8];
#pragma unroll
            for (int i = 0; i < 8; ++i) { o[i] = sigmoidf_(p[i] + v[i]); if (isw) o[i] = -0.6065306597126334f * o[i]; }
            *(u32x4*)(ob + (size_t)row * 1024 + col) = pack8(o);
            __builtin_amdgcn_sched_barrier(0);
        EPI_LOOP_END
    }
};
struct EpiG2 {
    const bf16_t* PROJ; bf16_t* MERGED;
    __device__ __forceinline__ void operator()(const f32x4 (&acc)[2][2][4][2], const pg8::Unit& u, int wr, int wc, int fr, int fq) const {
        const int z = u.z;
        EPI_LOOP_BEGIN
            float g[8]; unpack8(*(const u32x4*)(PROJ + (size_t)row * NP + C_G + z * 2048 + col), g);
            bf16_t* mp = MERGED + (size_t)row * D + col;
            if (z == 0) {
#pragma unroll
                for (int i = 0; i < 8; ++i) v[i] *= g[i];
            } else {
                float mm[8]; unpack8(*(const u32x4*)mp, mm);
#pragma unroll
                for (int i = 0; i < 8; ++i) v[i] = mm[i] + v[i] * g[i];
            }
            *(u32x4*)mp = pack8(v);
        EPI_LOOP_END
    }
};
struct EpiG3 {
    float* H;
    __device__ __forceinline__ void operator()(const f32x4 (&acc)[2][2][4][2], const pg8::Unit& u, int wr, int wc, int fr, int fq) const {
        EPI_LOOP_BEGIN
            float* hp = H + (size_t)row * D + col;
            const f32x4 h0 = *(const f32x4*)hp, h1 = *(const f32x4*)(hp + 4);
            *(f32x4*)hp = (f32x4){h0[0] + v[0], h0[1] + v[1], h0[2] + v[2], h0[3] + v[3]};
            *(f32x4*)(hp + 4) = (f32x4){h1[0] + v[4], h1[1] + v[5], h1[2] + v[6], h1[3] + v[7]};
        EPI_LOOP_END
    }
};

__device__ __forceinline__ int win_dest_row(int c) {
    if (c < 7168) return c;
    if (c < 7176) return C_IG + (c - 7168);
    if (c < 11272) return c - 8;
    if (c < 11400) return C_WD + (c - 11272);
    return c - 136;
}
template <bool WIN>
__device__ __forceinline__ void transpose_item(const float* W, int K, int N, bf16_t* WT, LAS float* scr, int item, int lane) {
    const int nblk = (N + 31) / 32, kb = item / nblk, nb = item % nblk, k0 = 64 * kb, n0 = 32 * nb;
    const int nn = n0 + (lane & 31);
#pragma unroll 8
    for (int i = 0; i < 32; ++i) { const int kk = 2 * i + (lane >> 5); scr[kk * 33 + (lane & 31)] = (nn < N) ? W[(size_t)(k0 + kk) * N + nn] : 0.f; }
    LDS_WAIT();
    const int c = lane & 7;
#pragma unroll
    for (int j = 0; j < 4; ++j) { const int n = (lane >> 3) + 8 * j; const LAS float* s = scr + (8 * c) * 33 + n;
        u32x4 o; o.x = cvt_pk_bf16(s[0 * 33], s[1 * 33]); o.y = cvt_pk_bf16(s[2 * 33], s[3 * 33]); o.z = cvt_pk_bf16(s[4 * 33], s[5 * 33]); o.w = cvt_pk_bf16(s[6 * 33], s[7 * 33]);
        if (n0 + n < N) { const int dr = WIN ? win_dest_row(n0 + n) : (n0 + n); *(u32x4*)(WT + (size_t)dr * K + k0 + 8 * c) = o; } }
    LDS_WAIT();
}

template <bool WIN, bool ZF>
__device__ __forceinline__ void tr_item(const float* W, int N, bf16_t* WT, int ldt, int kcol0, int item, int lane) {
    const int nblk = (N + 63) / 64, kb = item / nblk, nb = item - kb * nblk, k0 = 64 * kb, n = 64 * nb + lane;
    if (n >= N) return;
    float x[64];
#pragma unroll
    for (int i = 0; i < 64; ++i) x[i] = W[(size_t)(k0 + i) * N + n];
    const int dr = WIN ? win_dest_row(n) : n;
    bf16_t* row = WT + (size_t)dr * ldt;
#pragma unroll
    for (int g = 0; g < 8; ++g) { u32x4 o; o.x = cvt_pk_bf16(x[8 * g], x[8 * g + 1]); o.y = cvt_pk_bf16(x[8 * g + 2], x[8 * g + 3]); o.z = cvt_pk_bf16(x[8 * g + 4], x[8 * g + 5]); o.w = cvt_pk_bf16(x[8 * g + 6], x[8 * g + 7]);
        *(u32x4*)(row + kcol0 + k0 + 8 * g) = o; }
    if (ZF) {
#pragma unroll
        for (int g = 0; g < 32; ++g) if (g * 8 < kcol0 || g * 8 >= kcol0 + 64) *(u32x4*)(row + 8 * g) = (u32x4){0u, 0u, 0u, 0u};
    }
}

__device__ __forceinline__ void rms_row(const float* src, float* Hrow, const float* g, bf16_t* xn, int lane) {
    f32x4 v[8]; float ss = 0.f;
#pragma unroll
    for (int j = 0; j < 8; ++j) { v[j] = *(const f32x4*)(src + 256 * j + 4 * lane); ss += (v[j][0] * v[j][0] + v[j][1] * v[j][1]) + (v[j][2] * v[j][2] + v[j][3] * v[j][3]); }
    if (Hrow) {
#pragma unroll
        for (int j = 0; j < 8; ++j) *(f32x4*)(Hrow + 256 * j + 4 * lane) = v[j];
    }
    const float rs = rsqrtf(wave_sum(ss) * (1.0f / D) + 1e-6f);
#pragma unroll
    for (int j = 0; j < 8; ++j) { const f32x4 gg = *(const f32x4*)(g + 256 * j + 4 * lane);
        u32x2 o; o.x = cvt_pk_bf16(v[j][0] * rs * gg[0], v[j][1] * rs * gg[1]); o.y = cvt_pk_bf16(v[j][2] * rs * gg[2], v[j][3] * rs * gg[3]);
        *(u32x2*)(xn + 256 * j + 4 * lane) = o; }
}

struct Args { const float* in[23]; float* out; unsigned char* ws; };

constexpr int TB = 32, NBLK = (T + TB - 1) / TB;
constexpr int ST_FLOATS = 13312;
constexpr int OB_OFF = 2 * ST_FLOATS;
constexpr int MB_OFF = OB_OFF + 2 * 1024;

constexpr int NCH = 129, NSTREAM = 32, ITEM_ELEMS = 129 * 128, NITEMS_LA = NSTREAM * NCH;
constexpr int L_QA = 0, L_KB = 17408, L_QC = 34816, L_VT = 52224, L_ST = 70656, L_PB = 105472, L_SC = 114688;
constexpr int LDQ = 136, LDT = 72;
struct LaCtx { const bf16_t* PROJ; const float* AF; const bf16_t* BQK; const float* IL; bf16_t* DSI; bf16_t* DS; float* DEC; float* BEND; float* MLOC; float* MPREV; bf16_t* ORAW; float* DEN; float* MST; };
__device__ __forceinline__ bf16_t f2bf(float x) { return (bf16_t)(cvt_pk_bf16(x, 0.f) & 0xffffu); }
__device__ __forceinline__ float bf1(bf16_t b) { return __uint_as_float(((unsigned)b) << 16); }

__device__ __forceinline__ void la_phaseA(LAS unsigned char* lds, const LaCtx& X, int item) {
    int tid = threadIdx.x; asm volatile("" : "+v"(tid));
    const int wave = tid >> 6, lane = tid & 63, seg = tid >> 7, ch = tid & 127, fr = lane & 15, fq = lane >> 4;
    const int s = item / NCH, c = item - s * NCH, t0 = c * 64, mode = s >> 4;
    LAS bf16_t* KT = (LAS bf16_t*)(lds + L_QA);
    LAS bf16_t* VT = (LAS bf16_t*)(lds + L_VT);
    LAS float* SC = (LAS float*)(lds + L_SC);
    bf16_t* dsb = X.DSI + (size_t)item * ITEM_ELEMS;
    float kf[16]; bf16_t vr[16];
    if (mode == 0) {
        const int b = s >> 3, h = s & 7; const size_t rowbase = (size_t)b * T;
        float cs[16]; float run = 0.f;
#pragma unroll
        for (int i = 0; i < 16; ++i) { const int tt = t0 + seg * 16 + i; const bool ok = tt < T; const size_t row = rowbase + (ok ? tt : 0);
            const float lf = ok ? X.AF[row * 1024 + h * 128 + ch] : 0.f; run += lf; cs[i] = run;
            kf[i] = ok ? bf1(X.PROJ[row * NP + C_AF + h * 128 + ch]) : 0.f; vr[i] = ok ? X.PROJ[row * NP + C_AI + h * 128 + ch] : (bf16_t)0; }
        SC[seg * 128 + ch] = run;
        LDS_BAR();
        float off = 0.f, tot = 0.f;
#pragma unroll
        for (int s2 = 0; s2 < 4; ++s2) { const float x = SC[s2 * 128 + ch]; if (s2 < seg) off += x; tot += x; }
#pragma unroll
        for (int i = 0; i < 16; ++i) kf[i] *= __expf(tot - (off + cs[i]));
        if (seg == 0) X.DEC[((size_t)s * NCH + c) * 128 + ch] = __expf(tot);
    } else {
        const int bhm = (s - 16) >> 1, vhalf = (s - 16) & 1, b = bhm >> 2, h = bhm & 3; const size_t rowbase = (size_t)b * T;
#pragma unroll
        for (int i = 0; i < 16; ++i) { const int tt = t0 + seg * 16 + i; const bool ok = tt < T; const size_t row = rowbase + (ok ? tt : 0);
            kf[i] = ok ? bf1(X.BQK[row * 1024 + 512 + h * 128 + ch]) : 0.f;
            vr[i] = ok ? X.PROJ[row * NP + C_BV + h * 256 + vhalf * 128 + ch] : (bf16_t)0; }
        if (wave == 0) {
            const int tt = t0 + lane; const bool ok = tt < T; const size_t row = rowbase + (ok ? tt : 0);
            const float lfv = ok ? X.IL[row * 8 + 4 + h] : 0.f, igv = ok ? X.IL[row * 8 + h] : -1e30f;
            float bcs = lfv;
#pragma unroll
            for (int o = 1; o < 64; o <<= 1) { const float x = __shfl_up(bcs, o); if (lane >= o) bcs += x; }
            const float g = ok ? igv - bcs : -1e30f;
            float gm = g;
#pragma unroll
            for (int o = 1; o < 64; o <<= 1) gm = fmaxf(gm, __shfl_xor(gm, o));
            const float bend = __shfl(bcs, 63);
            SC[1024 + lane] = __expf(g - gm);
            if (lane == 0 && vhalf == 0) { X.BEND[bhm * NCH + c] = bend; X.MLOC[bhm * NCH + c] = bend + gm; }
        }
        LDS_BAR();
        float pn = 0.f;
#pragma unroll
        for (int i = 0; i < 16; ++i) { kf[i] *= SC[1024 + seg * 16 + i]; pn += kf[i]; }
        SC[512 + seg * 128 + ch] = pn;
    }
    {
        u32x4 k0, k1, v0, v1;
        k0.x = cvt_pk_bf16(kf[0], kf[1]); k0.y = cvt_pk_bf16(kf[2], kf[3]); k0.z = cvt_pk_bf16(kf[4], kf[5]); k0.w = cvt_pk_bf16(kf[6], kf[7]);
        k1.x = cvt_pk_bf16(kf[8], kf[9]); k1.y = cvt_pk_bf16(kf[10], kf[11]); k1.z = cvt_pk_bf16(kf[12], kf[13]); k1.w = cvt_pk_bf16(kf[14], kf[15]);
        v0.x = vr[0] | ((unsigned)vr[1] << 16); v0.y = vr[2] | ((unsigned)vr[3] << 16); v0.z = vr[4] | ((unsigned)vr[5] << 16); v0.w = vr[6] | ((unsigned)vr[7] << 16);
        v1.x = vr[8] | ((unsigned)vr[9] << 16); v1.y = vr[10] | ((unsigned)vr[11] << 16); v1.z = vr[12] | ((unsigned)vr[13] << 16); v1.w = vr[14] | ((unsigned)vr[15] << 16);
        *(LAS u32x4*)(KT + ch * LDT + seg * 16) = k0; *(LAS u32x4*)(KT + ch * LDT + seg * 16 + 8) = k1;
        *(LAS u32x4*)(VT + ch * LDT + seg * 16) = v0; *(LAS u32x4*)(VT + ch * LDT + seg * 16 + 8) = v1;
    }
    LDS_BAR();
    if (mode == 1 && seg == 0) dsb[128 * 128 + ch] = f2bf((SC[512 + ch] + SC[640 + ch]) + (SC[768 + ch] + SC[896 + ch]));
    {
        const int v0 = wave * 16;
        bf16x8 bv[2];
#pragma unroll
        for (int k = 0; k < 2; ++k) bv[k] = *(const LAS bf16x8*)(VT + (v0 + fr) * LDT + k * 32 + fq * 8);
#pragma unroll
        for (int nb = 0; nb < 8; ++nb) { const int d0 = nb * 16; f32x4 acc = (f32x4){0.f, 0.f, 0.f, 0.f};
#pragma unroll
            for (int k = 0; k < 2; ++k) { const bf16x8 a = *(const LAS bf16x8*)(KT + (d0 + fr) * LDT + k * 32 + fq * 8); acc = __builtin_amdgcn_mfma_f32_16x16x32_bf16(a, bv[k], acc, 0, 0, 0); }
            u32x2 o; o.x = cvt_pk_bf16(acc[0], acc[1]); o.y = cvt_pk_bf16(acc[2], acc[3]);
            *(u32x2*)(dsb + (size_t)(v0 + fr) * 128 + d0 + fq * 4) = o; }
    }
    LDS_BAR();
}

__device__ __forceinline__ void la_scan(const LaCtx& X) {
    int tid = threadIdx.x; asm volatile("" : "+v"(tid));
    const int task = blockIdx.x * NTHREADS + tid;
    if (task >= NSTREAM * 2064) return;
    const int s = task / 2064, rem = task - s * 2064, row = rem >> 4, d8 = (rem & 15) * 8, mode = s >> 4;
    if (mode == 0 && row == 128) return;
    bf16_t* base = X.DS + (size_t)s * NCH * ITEM_ELEMS + row * 128 + d8;
    const bf16_t* ibase = X.DSI + (size_t)s * NCH * ITEM_ELEMS + row * 128 + d8;
    const float* decb = X.DEC + (size_t)(s & 15) * NCH * 128 + d8;
    const int bhm = (s & 15) >> 1; const bool wr_m = (mode == 1) && ((s & 1) == 0) && (rem == 0);
    const float* bendp = X.BEND + bhm * NCH; const float* mlocp = X.MLOC + bhm * NCH;
    float S[8];
#pragma unroll
    for (int i = 0; i < 8; ++i) S[i] = 0.f;
    float m = 0.f;
    u32x4 x[4], y[4]; f32x4 da[4], db[4], ea[4], eb[4]; float be[4], ml[4], be2[4], ml2[4];
#pragma unroll
    for (int j = 0; j < 4; ++j) { x[j] = *(const u32x4*)(ibase + (size_t)j * ITEM_ELEMS);
        if (mode == 0) { da[j] = *(const f32x4*)(decb + j * 128); db[j] = *(const f32x4*)(decb + j * 128 + 4); be[j] = 0.f; ml[j] = 0.f; }
        else { be[j] = bendp[j]; ml[j] = mlocp[j]; da[j] = (f32x4){0.f, 0.f, 0.f, 0.f}; db[j] = da[j]; } }
    for (int c0 = 0; c0 < NCH; c0 += 4) {
#pragma unroll
        for (int j = 0; j < 4; ++j) { const int cn = c0 + 4 + j;
            if (cn < NCH) { y[j] = *(const u32x4*)(ibase + (size_t)cn * ITEM_ELEMS);
                if (mode == 0) { ea[j] = *(const f32x4*)(decb + cn * 128); eb[j] = *(const f32x4*)(decb + cn * 128 + 4); be2[j] = 0.f; ml2[j] = 0.f; }
                else { be2[j] = bendp[cn]; ml2[j] = mlocp[cn]; ea[j] = (f32x4){0.f, 0.f, 0.f, 0.f}; eb[j] = ea[j]; } }
            else { y[j] = (u32x4){0u, 0u, 0u, 0u}; ea[j] = (f32x4){0.f, 0.f, 0.f, 0.f}; eb[j] = ea[j]; be2[j] = 0.f; ml2[j] = 0.f; } }
#pragma unroll
        for (int j = 0; j < 4; ++j) { const int c = c0 + j;
            if (c < NCH) {
                *(u32x4*)(base + (size_t)c * ITEM_ELEMS) = pack8(S);
                float xv[8]; unpack8(x[j], xv);
                if (mode == 0) {
#pragma unroll
                    for (int i = 0; i < 4; ++i) { S[i] = da[j][i] * S[i] + xv[i]; S[4 + i] = db[j][i] * S[4 + i] + xv[4 + i]; }
                } else {
                    const float mnew = fmaxf(be[j] + m, ml[j]); const float carry = __expf(be[j] + m - mnew), wl = __expf(ml[j] - mnew);
                    if (wr_m) X.MPREV[bhm * NCH + c] = m;
#pragma unroll
                    for (int i = 0; i < 8; ++i) S[i] = carry * S[i] + wl * xv[i];
                    m = mnew;
                }
            } }
#pragma unroll
        for (int j = 0; j < 4; ++j) { x[j] = y[j]; da[j] = ea[j]; db[j] = eb[j]; be[j] = be2[j]; ml[j] = ml2[j]; }
    }
}

__device__ __forceinline__ void la_phaseC(LAS unsigned char* lds, const LaCtx& X, int item) {
    int tid = threadIdx.x; asm volatile("" : "+v"(tid));
    const int wave = tid >> 6, lane = tid & 63, seg = tid >> 7, ch = tid & 127, fr = lane & 15, fq = lane >> 4;
    const int s = item / NCH, c = item - s * NCH, t0 = c * 64, mode = s >> 4;
    LAS bf16_t* QA = (LAS bf16_t*)(lds + L_QA); LAS bf16_t* KB = (LAS bf16_t*)(lds + L_KB); LAS bf16_t* QC = (LAS bf16_t*)(lds + L_QC);
    LAS bf16_t* VT = (LAS bf16_t*)(lds + L_VT); LAS bf16_t* ST = (LAS bf16_t*)(lds + L_ST); LAS bf16_t* PB = (LAS bf16_t*)(lds + L_PB);
    LAS float* SC = (LAS float*)(lds + L_SC);
    const bf16_t* dsb = X.DS + (size_t)item * ITEM_ELEMS;
#pragma unroll
    for (int j = 0; j < 4; ++j) { const int q = tid + 512 * j, row = q >> 4, cc = (q & 15) * 8; *(LAS u32x4*)(ST + row * LDQ + cc) = *(const u32x4*)(dsb + row * 128 + cc); }
    size_t rowbase; int colbase, hden = 0; bool wden = false;
    bf16_t vr[16];
    const int tg = tid >> 4, chb = (tid & 15) * 8;
    if (mode == 0) {
        const int b = s >> 3, h = s & 7; rowbase = (size_t)b * T; colbase = h * 128;
        float lfv[2][8]; u32x4 qraw[2], kraw[2];
#pragma unroll
        for (int j = 0; j < 2; ++j) { const int tt = t0 + 2 * tg + j; const bool ok = tt < T; const size_t row = rowbase + (ok ? tt : 0);
            const f32x4 a0 = *(const f32x4*)(X.AF + row * 1024 + h * 128 + chb), a1 = *(const f32x4*)(X.AF + row * 1024 + h * 128 + chb + 4);
            const u32x4 qq = *(const u32x4*)(X.PROJ + row * NP + C_AQ + h * 128 + chb), kk = *(const u32x4*)(X.PROJ + row * NP + C_AF + h * 128 + chb);
#pragma unroll
            for (int i = 0; i < 4; ++i) { lfv[j][i] = ok ? a0[i] : 0.f; lfv[j][4 + i] = ok ? a1[i] : 0.f; }
            qraw[j] = ok ? qq : (u32x4){0u, 0u, 0u, 0u}; kraw[j] = ok ? kk : (u32x4){0u, 0u, 0u, 0u}; }
#pragma unroll
        for (int i = 0; i < 16; ++i) { const int tt = t0 + seg * 16 + i; const bool ok = tt < T; const size_t row = rowbase + (ok ? tt : 0);
            vr[i] = ok ? X.PROJ[row * NP + C_AI + h * 128 + ch] : (bf16_t)0; }
        float incl[8], gsum[8];
#pragma unroll
        for (int i = 0; i < 8; ++i) { gsum[i] = lfv[0][i] + lfv[1][i]; float x = gsum[i];
            float y = __shfl_up(x, 16); if (lane >= 16) x += y;
            y = __shfl_up(x, 32); if (lane >= 32) x += y;
            incl[i] = x; }
        if (lane >= 48) {
#pragma unroll
            for (int i = 0; i < 8; ++i) SC[wave * 128 + chb + i] = incl[i];
        }
        LDS_BAR();
        float cg0[8], cg1[8], refv[8];
#pragma unroll
        for (int i = 0; i < 8; ++i) { float off = 0.f, ref = 0.f;
#pragma unroll
            for (int w = 0; w < 8; ++w) { const float x = SC[w * 128 + chb + i]; if (w < wave) off += x; if (w < 4) ref += x; }
            const float base = off + (incl[i] - gsum[i]);
            cg0[i] = base + lfv[0][i]; cg1[i] = base + gsum[i]; refv[i] = ref; }
#pragma unroll
        for (int j = 0; j < 2; ++j) { const int t = 2 * tg + j; float qf[8], kf[8], e1[8], e2[8], e3[8];
            unpack8(qraw[j], qf); unpack8(kraw[j], kf);
#pragma unroll
            for (int i = 0; i < 8; ++i) { const float cg = j ? cg1[i] : cg0[i]; e1[i] = qf[i] * __expf(cg - refv[i]); e2[i] = kf[i] * __expf(refv[i] - cg); e3[i] = qf[i] * __expf(cg); }
            *(LAS u32x4*)(QA + t * LDQ + chb) = pack8(e1); *(LAS u32x4*)(KB + t * LDQ + chb) = pack8(e2); *(LAS u32x4*)(QC + t * LDQ + chb) = pack8(e3); }
    } else {
        const int bhm = (s - 16) >> 1, vhalf = (s - 16) & 1, b = bhm >> 2, h = bhm & 3; rowbase = (size_t)b * T; colbase = 1024 + h * 256 + vhalf * 128; hden = h; wden = (vhalf == 0);
        u32x4 qraw[2];
#pragma unroll
        for (int j = 0; j < 2; ++j) { const int t = 2 * tg + j, tt = t0 + t; const bool ok = tt < T; const size_t row = rowbase + (ok ? tt : 0);
            const u32x4 qq = *(const u32x4*)(X.BQK + row * 1024 + h * 128 + chb), kk = *(const u32x4*)(X.BQK + row * 1024 + 512 + h * 128 + chb);
            qraw[j] = ok ? qq : (u32x4){0u, 0u, 0u, 0u};
            *(LAS u32x4*)(QA + t * LDQ + chb) = qraw[j]; *(LAS u32x4*)(KB + t * LDQ + chb) = ok ? kk : (u32x4){0u, 0u, 0u, 0u}; }
#pragma unroll
        for (int i = 0; i < 16; ++i) { const int tt = t0 + seg * 16 + i; const bool ok = tt < T; const size_t row = rowbase + (ok ? tt : 0);
            vr[i] = ok ? X.PROJ[row * NP + C_BV + h * 256 + vhalf * 128 + ch] : (bf16_t)0; }
        if (wave == 0) {
            const int tt = t0 + lane; const bool ok = tt < T; const size_t row = rowbase + (ok ? tt : 0);
            const float lfv = ok ? X.IL[row * 8 + 4 + h] : 0.f, igv = ok ? X.IL[row * 8 + h] : -1e30f;
            float bcs = lfv;
#pragma unroll
            for (int o = 1; o < 64; o <<= 1) { const float x = __shfl_up(bcs, o); if (lane >= o) bcs += x; }
            const float g = ok ? igv - bcs : -1e30f;
            float gp = g;
#pragma unroll
            for (int o = 1; o < 64; o <<= 1) { const float x = __shfl_up(gp, o); if (lane >= o) gp = fmaxf(gp, x); }
            const float mprev = X.MPREV[bhm * NCH + c];
            const float mt = fmaxf(bcs + mprev, bcs + gp);
            SC[1088 + lane] = g; SC[1152 + lane] = bcs - mt; SC[1216 + lane] = __expf(bcs + mprev - mt); SC[1280 + lane] = mt;
        }
        if (tid < 128) SC[1344 + tid] = bf1(dsb[128 * 128 + tid]);
        LDS_BAR();
#pragma unroll
        for (int j = 0; j < 2; ++j) { const int t = 2 * tg + j; float qf[8]; unpack8(qraw[j], qf); const float it = SC[1216 + t];
#pragma unroll
            for (int i = 0; i < 8; ++i) qf[i] *= it;
            *(LAS u32x4*)(QC + t * LDQ + chb) = pack8(qf); }
    }
    {
        u32x4 v0, v1;
        v0.x = vr[0] | ((unsigned)vr[1] << 16); v0.y = vr[2] | ((unsigned)vr[3] << 16); v0.z = vr[4] | ((unsigned)vr[5] << 16); v0.w = vr[6] | ((unsigned)vr[7] << 16);
        v1.x = vr[8] | ((unsigned)vr[9] << 16); v1.y = vr[10] | ((unsigned)vr[11] << 16); v1.z = vr[12] | ((unsigned)vr[13] << 16); v1.w = vr[14] | ((unsigned)vr[15] << 16);
        *(LAS u32x4*)(VT + ch * LDT + seg * 16) = v0; *(LAS u32x4*)(VT + ch * LDT + seg * 16 + 8) = v1;
    }
    LDS_BAR();
    const int t0b = (wave >> 1) * 16;
    {
        bf16x8 bq[4];
#pragma unroll
        for (int k = 0; k < 4; ++k) bq[k] = *(const LAS bf16x8*)(QA + (t0b + fr) * LDQ + k * 32 + fq * 8);
#pragma unroll
        for (int sbi = 0; sbi < 2; ++sbi) { const int s0 = ((wave & 1) * 2 + sbi) * 16;
            u32x2 o = (u32x2){0u, 0u};
            if (s0 <= t0b + 15) {
                f32x4 acc = (f32x4){0.f, 0.f, 0.f, 0.f};
#pragma unroll
                for (int k = 0; k < 4; ++k) { const bf16x8 a = *(const LAS bf16x8*)(KB + (s0 + fr) * LDQ + k * 32 + fq * 8); acc = __builtin_amdgcn_mfma_f32_16x16x32_bf16(a, bq[k], acc, 0, 0, 0); }
                const int t = t0b + fr; float p[4];
                float rt = 0.f; f32x4 ct = (f32x4){0.f, 0.f, 0.f, 0.f};
                if (mode == 1) { rt = SC[1152 + t]; ct = *(const LAS f32x4*)(SC + 1088 + s0 + fq * 4); }
#pragma unroll
                for (int j = 0; j < 4; ++j) { const int sidx = s0 + fq * 4 + j; float v = acc[j]; if (mode == 1) v *= __expf(rt + ct[j]); p[j] = (sidx <= t) ? v : 0.f; }
                o.x = cvt_pk_bf16(p[0], p[1]); o.y = cvt_pk_bf16(p[2], p[3]);
            }
            *(LAS u32x2*)(PB + (t0b + fr) * LDT + s0 + fq * 4) = o; }
    }
    LDS_BAR();
    {
        bf16x8 bp[2], bc[4];
#pragma unroll
        for (int k = 0; k < 2; ++k) bp[k] = *(const LAS bf16x8*)(PB + (t0b + fr) * LDT + k * 32 + fq * 8);
#pragma unroll
        for (int k = 0; k < 4; ++k) bc[k] = *(const LAS bf16x8*)(QC + (t0b + fr) * LDQ + k * 32 + fq * 8);
        const int tt = t0 + t0b + fr;
#pragma unroll
        for (int vbi = 0; vbi < 4; ++vbi) { const int v0 = ((wave & 1) * 4 + vbi) * 16; f32x4 acc = (f32x4){0.f, 0.f, 0.f, 0.f};
#pragma unroll
            for (int k = 0; k < 2; ++k) { const bf16x8 a = *(const LAS bf16x8*)(VT + (v0 + fr) * LDT + k * 32 + fq * 8); acc = __builtin_amdgcn_mfma_f32_16x16x32_bf16(a, bp[k], acc, 0, 0, 0); }
#pragma unroll
            for (int k = 0; k < 4; ++k) { const bf16x8 a = *(const LAS bf16x8*)(ST + (v0 + fr) * LDQ + k * 32 + fq * 8); acc = __builtin_amdgcn_mfma_f32_16x16x32_bf16(a, bc[k], acc, 0, 0, 0); }
            if (tt < T) { u32x2 o; o.x = cvt_pk_bf16(acc[0], acc[1]); o.y = cvt_pk_bf16(acc[2], acc[3]); *(u32x2*)(X.ORAW + (rowbase + tt) * 3072 + colbase + v0 + fq * 4) = o; } }
    }
    if (mode == 1 && wden && tid < 64) {
        const int t = tid; float sum = 0.f, qn = 0.f;
#pragma unroll
        for (int k = 0; k < 8; ++k) { float f8[8]; unpack8(*(const LAS u32x4*)(PB + t * LDT + k * 8), f8);
#pragma unroll
            for (int i = 0; i < 8; ++i) sum += f8[i]; }
#pragma unroll
        for (int k = 0; k < 16; ++k) { float f8[8]; unpack8(*(const LAS u32x4*)(QC + t * LDQ + k * 8), f8);
#pragma unroll
            for (int i = 0; i < 8; ++i) qn += f8[i] * SC[1344 + k * 8 + i]; }
        const int tt = t0 + t;
        if (tt < T) { X.DEN[(rowbase + tt) * 4 + hden] = sum + qn; X.MST[(rowbase + tt) * 4 + hden] = SC[1280 + t]; }
    }
    LDS_BAR();
}

constexpr int RW_ITEMS = 32 * NCH;
constexpr size_t RWI_P = 0, RWI_R = 8192, RWI_DEC = 16384, RWI_W = 16640, RWI_U = 24832, RWI_BYTES = 33024;
struct RwCtx { const bf16_t* CRKV; const bf16_t* CW; const bf16_t* CA; const float* kkp; const float* kap; unsigned char* RWI; bf16_t* SRW; bf16_t* ORAW; };
constexpr int RW_SCR = 114944;

struct RwTok { float r[8], kp[8], av[8], bv[8], v[8], cw[8], lw[8]; };
__device__ __forceinline__ void rw_prep(LAS float* SCR, const RwCtx& X, int b, int h, int t0, int tid, RwTok& K) {
    const int t = tid >> 3, dq = tid & 7, lane = tid & 63, wave = tid >> 6;
    const int tt = t0 + t; const bool ok = tt < T; const size_t row = (size_t)b * T + (ok ? tt : 0);
    const bf16_t* pr = X.CRKV + row * 3072 + h * 64 + dq * 8;
    float kr[8], aa[8];
    unpack8(*(const u32x4*)pr, K.r); unpack8(*(const u32x4*)(pr + 1024), kr); unpack8(*(const u32x4*)(pr + 2048), K.v);
    unpack8(*(const u32x4*)(X.CA + row * 1024 + h * 64 + dq * 8), aa); unpack8(*(const u32x4*)(X.CW + row * 1024 + h * 64 + dq * 8), K.lw);
    const f32x4 p0 = *(const f32x4*)(X.kkp + h * 64 + dq * 8), p1 = *(const f32x4*)(X.kkp + h * 64 + dq * 8 + 4);
    const f32x4 q0 = *(const f32x4*)(X.kap + h * 64 + dq * 8), q1 = *(const f32x4*)(X.kap + h * 64 + dq * 8 + 4);
    float kk[8]; float ss = 0.f;
#pragma unroll
    for (int i = 0; i < 8; ++i) { kk[i] = kr[i] * (i < 4 ? p0[i & 3] : p1[i & 3]); ss += kk[i] * kk[i]; }
    ss += __shfl_xor(ss, 1); ss += __shfl_xor(ss, 2); ss += __shfl_xor(ss, 4);
    const float inv = 1.0f / fmaxf(sqrtf(ss), 1e-12f);
#pragma unroll
    for (int i = 0; i < 8; ++i) { const float kn = kk[i] * inv, ka = (i < 4 ? q0[i & 3] : q1[i & 3]);
        K.av[i] = -kn; K.bv[i] = kn * aa[i]; K.kp[i] = kr[i] * (1.0f + (aa[i] - 1.0f) * ka);
        if (!ok) { K.av[i] = 0.f; K.bv[i] = 0.f; K.kp[i] = 0.f; K.r[i] = 0.f; K.v[i] = 0.f; K.lw[i] = 0.f; } }
#pragma unroll
    for (int i = 0; i < 8; ++i) { float x = K.lw[i];
#pragma unroll
        for (int o = 8; o < 64; o <<= 1) { const float y = __shfl_up(x, o); if (lane >= o) x += y; }
        K.cw[i] = x; }
    if ((lane >> 3) == 7) {
#pragma unroll
        for (int i = 0; i < 8; ++i) SCR[wave * 64 + dq * 8 + i] = K.cw[i];
    }
    LDS_BAR();
#pragma unroll
    for (int i = 0; i < 8; ++i) { float off = 0.f;
#pragma unroll
        for (int w = 0; w < 7; ++w) if (w < wave) off += SCR[w * 64 + dq * 8 + i];
        K.cw[i] += off; }
}
__device__ __forceinline__ void rw_refs(const LAS float* SCR, int dq, float (&ref)[8], float (&cend)[8]) {
#pragma unroll
    for (int i = 0; i < 8; ++i) { float a = 0.f, b = 0.f;
#pragma unroll
        for (int w = 0; w < 8; ++w) { const float x = SCR[w * 64 + dq * 8 + i]; if (w < 4) a += x; b += x; }
        ref[i] = a; cend[i] = a + (b - a); cend[i] = b; }
}
__device__ __forceinline__ u32x4 pack8v(const float (&f)[8]) { return pack8(f); }

__device__ __forceinline__ void rw_phaseA(LAS unsigned char* lds, const RwCtx& X, int item) {
    int tid = threadIdx.x; asm volatile("" : "+v"(tid));
    const int wave = tid >> 6, lane = tid & 63, fr = lane & 15, fq = lane >> 4, t = tid >> 3, dq = tid & 7;
    const int bh = item / NCH, c = item - bh * NCH, b = bh >> 4, h = bh & 15, t0 = c * 64;
    LAS bf16_t* AT = (LAS bf16_t*)(lds + 0); LAS bf16_t* BB = (LAS bf16_t*)(lds + 9216); LAS bf16_t* KB = (LAS bf16_t*)(lds + 18432);
    LAS bf16_t* BtT = (LAS bf16_t*)(lds + 27648); LAS bf16_t* KtT = (LAS bf16_t*)(lds + 36864); LAS bf16_t* VT = (LAS bf16_t*)(lds + 46080);
    LAS float* XS = (LAS float*)(lds + 55296);
    LAS float* LAB = (LAS float*)(lds + 88320);
    LAS bf16_t* LAK = (LAS bf16_t*)(lds + 105728);
    LAS float* SCR = (LAS float*)(lds + RW_SCR);
    LAS bf16_t* Wt = (LAS bf16_t*)(lds + 0); LAS bf16_t* Ut = (LAS bf16_t*)(lds + 8192);
    LAS bf16_t* WT = (LAS bf16_t*)(lds + 18432); LAS bf16_t* UT = (LAS bf16_t*)(lds + 105728);
    unsigned char* gi = X.RWI + (size_t)item * RWI_BYTES;
    {
        RwTok K; rw_prep(SCR, X, b, h, t0, tid, K);
        float e1[8], e2[8], e3[8], e4[8];
        float refv[8], cendv[8]; rw_refs(SCR, dq, refv, cendv);
#pragma unroll
        for (int i = 0; i < 8; ++i) { const float ref = refv[i], cend = cendv[i];
            const float as = K.av[i] * __expf(K.cw[i] - K.lw[i]);
            XS[t * 129 + dq * 8 + i] = as;
            e1[i] = K.av[i] * __expf(K.cw[i] - K.lw[i] - ref); const float eb = __expf(ref - K.cw[i]); e2[i] = K.bv[i] * eb; e3[i] = K.kp[i] * eb;
            const float et = __expf(cend - K.cw[i]); e4[i] = et;
            BtT[(dq * 8 + i) * 72 + t] = f2bf(K.bv[i] * et); KtT[(dq * 8 + i) * 72 + t] = f2bf(K.kp[i] * et); VT[(dq * 8 + i) * 72 + t] = f2bf(K.v[i]);
            if (t == 0) *(float*)(gi + RWI_DEC + (dq * 8 + i) * 4) = __expf(cend); }
        *(LAS u32x4*)(AT + t * 72 + dq * 8) = pack8(e1); *(LAS u32x4*)(BB + t * 72 + dq * 8) = pack8(e2); *(LAS u32x4*)(KB + t * 72 + dq * 8) = pack8(e3);
        (void)e4;
    }
    LDS_BAR();
    const int t0b = (wave >> 1) * 16;
    {
        bf16x8 fa[2];
#pragma unroll
        for (int k = 0; k < 2; ++k) fa[k] = *(const LAS bf16x8*)(AT + (t0b + fr) * 72 + k * 32 + fq * 8);
#pragma unroll
        for (int sbi = 0; sbi < 2; ++sbi) { const int s0 = ((wave & 1) * 2 + sbi) * 16;
            f32x4 acc = (f32x4){0.f, 0.f, 0.f, 0.f}, acc2 = acc;
            if (s0 <= t0b + 15) {
#pragma unroll
                for (int k = 0; k < 2; ++k) { const bf16x8 fb = *(const LAS bf16x8*)(BB + (s0 + fr) * 72 + k * 32 + fq * 8), fk = *(const LAS bf16x8*)(KB + (s0 + fr) * 72 + k * 32 + fq * 8);
                    acc = __builtin_amdgcn_mfma_f32_16x16x32_bf16(fa[k], fb, acc, 0, 0, 0);
                    acc2 = __builtin_amdgcn_mfma_f32_16x16x32_bf16(fk, fa[k], acc2, 0, 0, 0); }
            }
#pragma unroll
            for (int j = 0; j < 4; ++j) { const int tt = t0b + fq * 4 + j, sidx = s0 + fr; LAB[tt * 68 + sidx] = (sidx < tt) ? acc[j] : 0.f; }
            float p[4];
#pragma unroll
            for (int j = 0; j < 4; ++j) p[j] = (s0 + fq * 4 + j < t0b + fr) ? acc2[j] : 0.f;
            u32x2 o; o.x = cvt_pk_bf16(p[0], p[1]); o.y = cvt_pk_bf16(p[2], p[3]);
            *(LAS u32x2*)(LAK + (t0b + fr) * 72 + s0 + fq * 4) = o; }
    }
    LDS_BAR();
    {
        bf16x8 fl[2];
#pragma unroll
        for (int k = 0; k < 2; ++k) fl[k] = *(const LAS bf16x8*)(LAK + (t0b + fr) * 72 + k * 32 + fq * 8);
#pragma unroll
        for (int bi = 0; bi < 2; ++bi) { const int v0 = ((wave & 1) * 2 + bi) * 16; f32x4 acc = (f32x4){0.f, 0.f, 0.f, 0.f};
#pragma unroll
            for (int k = 0; k < 2; ++k) { const bf16x8 fv = *(const LAS bf16x8*)(VT + (v0 + fr) * 72 + k * 32 + fq * 8); acc = __builtin_amdgcn_mfma_f32_16x16x32_bf16(fl[k], fv, acc, 0, 0, 0); }
#pragma unroll
            for (int j = 0; j < 4; ++j) XS[(t0b + fq * 4 + j) * 129 + 64 + v0 + fr] = acc[j]; }
    }
    LDS_BAR();
    int tid_s = threadIdx.x; asm volatile("" : "+v"(tid_s));
    if (tid_s < 128) {
        float x[64];
        int zv = 0; asm volatile("" : "+v"(zv));
        const LAS float* LABv = LAB + zv;
#pragma unroll
        for (int i = 0; i < 64; ++i) x[i] = XS[i * 129 + tid_s];
#pragma unroll
        for (int tt = 1; tt < 64; ++tt) { float a = x[tt];
#pragma unroll
            for (int s4 = 0; s4 < (tt + 3) / 4; ++s4) { const f32x4 l4 = *(const LAS f32x4*)(LABv + tt * 68 + s4 * 4);
                a += l4[0] * x[s4 * 4]; if (s4 * 4 + 1 < tt) a += l4[1] * x[s4 * 4 + 1]; if (s4 * 4 + 2 < tt) a += l4[2] * x[s4 * 4 + 2]; if (s4 * 4 + 3 < tt) a += l4[3] * x[s4 * 4 + 3]; }
            x[tt] = a;
#ifdef SOLVER_SB
            __builtin_amdgcn_sched_barrier(0);
#endif
        }
        LAS bf16_t* rowT = (tid_s < 64) ? (WT + tid_s * 72) : (UT + (tid_s - 64) * 72);
        LAS bf16_t* colN = (tid_s < 64) ? (Wt + tid_s) : (Ut + (tid_s - 64));
#pragma unroll
        for (int g = 0; g < 8; ++g) { u32x4 o; o.x = cvt_pk_bf16(x[8 * g], x[8 * g + 1]); o.y = cvt_pk_bf16(x[8 * g + 2], x[8 * g + 3]); o.z = cvt_pk_bf16(x[8 * g + 4], x[8 * g + 5]); o.w = cvt_pk_bf16(x[8 * g + 6], x[8 * g + 7]);
            *(LAS u32x4*)(rowT + 8 * g) = o; }
#pragma unroll
        for (int i = 0; i < 64; ++i) colN[i * 64] = f2bf(x[i]);
    }
    LDS_BAR();
    {
        int tid = threadIdx.x; asm volatile("" : "+v"(tid));
        const int wave = tid >> 6, lane = tid & 63, fr = lane & 15, fq = lane >> 4;
        const int d0 = (wave >> 1) * 16;
        bf16x8 fb[2], fk2[2];
#pragma unroll
        for (int k = 0; k < 2; ++k) { fb[k] = *(const LAS bf16x8*)(BtT + (d0 + fr) * 72 + k * 32 + fq * 8); fk2[k] = *(const LAS bf16x8*)(KtT + (d0 + fr) * 72 + k * 32 + fq * 8); }
#pragma unroll
        for (int bi = 0; bi < 2; ++bi) { const int n0 = ((wave & 1) * 2 + bi) * 16; f32x4 accp = (f32x4){0.f, 0.f, 0.f, 0.f}; f32x4 accr = accp;
#pragma unroll
            for (int k = 0; k < 2; ++k) { const bf16x8 fw = *(const LAS bf16x8*)(WT + (n0 + fr) * 72 + k * 32 + fq * 8), fu = *(const LAS bf16x8*)(UT + (n0 + fr) * 72 + k * 32 + fq * 8), fv = *(const LAS bf16x8*)(VT + (n0 + fr) * 72 + k * 32 + fq * 8);
                accp = __builtin_amdgcn_mfma_f32_16x16x32_bf16(fw, fb[k], accp, 0, 0, 0);
                accr = __builtin_amdgcn_mfma_f32_16x16x32_bf16(fb[k], fu, accr, 0, 0, 0);
                accr = __builtin_amdgcn_mfma_f32_16x16x32_bf16(fk2[k], fv, accr, 0, 0, 0); }
            u32x2 op; op.x = cvt_pk_bf16(accp[0], accp[1]); op.y = cvt_pk_bf16(accp[2], accp[3]);
            *(u32x2*)(gi + RWI_P + ((size_t)(d0 + fr) * 64 + n0 + fq * 4) * 2) = op;
            u32x2 orr; orr.x = cvt_pk_bf16(accr[0], accr[1]); orr.y = cvt_pk_bf16(accr[2], accr[3]);
            *(u32x2*)(gi + RWI_R + ((size_t)((wave * 2 + bi) * 64 + lane)) * 8) = orr; }
#pragma unroll
        for (int j = 0; j < 2; ++j) { const int q = tid + 512 * j; *(u32x4*)(gi + RWI_W + (size_t)q * 16) = *(const LAS u32x4*)(lds + (size_t)q * 16); }
    }
    LDS_BAR();
}

__device__ __forceinline__ void rw_phaseB(LAS unsigned char* lds, const RwCtx& X, int bh) {
    int tid = threadIdx.x; asm volatile("" : "+v"(tid));
    const int wave = tid >> 6, lane = tid & 63, fr = lane & 15, fq = lane >> 4;
    const int d0 = (wave >> 1) * 16, vb0 = (wave & 1) * 2;
    f32x4 acc[2]; acc[0] = (f32x4){0.f, 0.f, 0.f, 0.f}; acc[1] = acc[0];
    const unsigned char* gi = X.RWI + (size_t)bh * NCH * RWI_BYTES;
    bf16x8 pa[4][2], pn[4][2]; u32x2 rf[4][2], rn[4][2]; f32x4 dc[4], dn[4];
#define RWB_LOAD(PA, RF, DC, cc) do { const unsigned char* g_ = gi + (size_t)(cc) * RWI_BYTES; \
        _Pragma("unroll") for (int k = 0; k < 2; ++k) PA[k] = *(const bf16x8*)(g_ + RWI_P + ((size_t)(d0 + fr) * 64 + k * 32 + fq * 8) * 2); \
        _Pragma("unroll") for (int bi = 0; bi < 2; ++bi) RF[bi] = *(const u32x2*)(g_ + RWI_R + ((size_t)((wave * 2 + bi) * 64 + lane)) * 8); \
        DC = *(const f32x4*)(g_ + RWI_DEC + (d0 + fq * 4) * 4); } while (0)
#pragma unroll
    for (int j = 0; j < 4; ++j) RWB_LOAD(pa[j], rf[j], dc[j], j);
    for (int c0 = 0; c0 < NCH; c0 += 4) {
#pragma unroll
        for (int j = 0; j < 4; ++j) { const int cn = c0 + 4 + j;
            if (cn < NCH) RWB_LOAD(pn[j], rn[j], dn[j], cn);
            else { pn[j][0] = pa[j][0]; pn[j][1] = pa[j][1]; rn[j][0] = rf[j][0]; rn[j][1] = rf[j][1]; dn[j] = dc[j]; } }
#pragma unroll
        for (int j = 0; j < 4; ++j) { const int c = c0 + j;
            if (c < NCH) {
                LAS bf16_t* STb = (LAS bf16_t*)(lds + (c & 1) * 9216);
                bf16_t* sg = X.SRW + ((size_t)bh * NCH + c) * 4096;
#pragma unroll
                for (int bi = 0; bi < 2; ++bi) { const int v0 = (vb0 + bi) * 16; u32x2 o; o.x = cvt_pk_bf16(acc[bi][0], acc[bi][1]); o.y = cvt_pk_bf16(acc[bi][2], acc[bi][3]);
                    *(LAS u32x2*)(STb + (v0 + fr) * 72 + d0 + fq * 4) = o; *(u32x2*)(sg + (v0 + fr) * 64 + d0 + fq * 4) = o; }
                LDS_BAR();
#pragma unroll
                for (int bi = 0; bi < 2; ++bi) { const int v0 = (vb0 + bi) * 16;
                    f32x4 n = (f32x4){dc[j][0] * acc[bi][0] + bflo(rf[j][bi].x), dc[j][1] * acc[bi][1] + bfhi(rf[j][bi].x), dc[j][2] * acc[bi][2] + bflo(rf[j][bi].y), dc[j][3] * acc[bi][3] + bfhi(rf[j][bi].y)};
#pragma unroll
                    for (int k = 0; k < 2; ++k) { const bf16x8 fs = *(const LAS bf16x8*)(STb + (v0 + fr) * 72 + k * 32 + fq * 8); n = __builtin_amdgcn_mfma_f32_16x16x32_bf16(pa[j][k], fs, n, 0, 0, 0); }
                    acc[bi] = n; }
            } }
#pragma unroll
        for (int j = 0; j < 4; ++j) { pa[j][0] = pn[j][0]; pa[j][1] = pn[j][1]; rf[j][0] = rn[j][0]; rf[j][1] = rn[j][1]; dc[j] = dn[j]; }
    }
#undef RWB_LOAD
    LDS_BAR();
}

__device__ __forceinline__ void rw_phaseC(LAS unsigned char* lds, const RwCtx& X, int item) {
    int tid = threadIdx.x; asm volatile("" : "+v"(tid));
    const int wave = tid >> 6, lane = tid & 63, fr = lane & 15, fq = lane >> 4, t = tid >> 3, dq = tid & 7;
    const int bh = item / NCH, c = item - bh * NCH, b = bh >> 4, h = bh & 15, t0 = c * 64;
    LAS bf16_t* RT = (LAS bf16_t*)(lds + 0); LAS bf16_t* BB = (LAS bf16_t*)(lds + 9216); LAS bf16_t* KB = (LAS bf16_t*)(lds + 18432);
    LAS bf16_t* RS = (LAS bf16_t*)(lds + 27648); LAS bf16_t* VT = (LAS bf16_t*)(lds + 36864); LAS bf16_t* ST = (LAS bf16_t*)(lds + 46080);
    LAS bf16_t* Wt = (LAS bf16_t*)(lds + 55296); LAS bf16_t* RB = (LAS bf16_t*)(lds + 64512); LAS bf16_t* RK = (LAS bf16_t*)(lds + 73728); LAS bf16_t* UT = (LAS bf16_t*)(lds + 82944);
    LAS float* SCR = (LAS float*)(lds + RW_SCR);
    const unsigned char* gi = X.RWI + (size_t)item * RWI_BYTES;
    const int t0b = (wave >> 1) * 16;
    float u0v[2][4];
    { const bf16_t* u0g = (const bf16_t*)(gi + RWI_U);
#pragma unroll
      for (int bi = 0; bi < 2; ++bi)
#pragma unroll
        for (int j = 0; j < 4; ++j) u0v[bi][j] = bf1(u0g[(t0b + fq * 4 + j) * 64 + ((wave & 1) * 2 + bi) * 16 + fr]); }
    {
        *(LAS u32x4*)(ST + t * 72 + dq * 8) = *(const u32x4*)(X.SRW + (size_t)item * 4096 + t * 64 + dq * 8);
        *(LAS u32x4*)(Wt + t * 72 + dq * 8) = *(const u32x4*)(gi + RWI_W + ((size_t)t * 64 + dq * 8) * 2);
    }
    {
        RwTok K; rw_prep(SCR, X, b, h, t0, tid, K);
        float e1[8], e2[8], e3[8], e4[8];
        float refv[8], cendv[8]; rw_refs(SCR, dq, refv, cendv); (void)cendv;
#pragma unroll
        for (int i = 0; i < 8; ++i) { const float ref = refv[i];
            e1[i] = K.r[i] * __expf(K.cw[i] - ref); const float eb = __expf(ref - K.cw[i]); e2[i] = K.bv[i] * eb; e3[i] = K.kp[i] * eb; e4[i] = K.r[i] * __expf(K.cw[i]);
            VT[(dq * 8 + i) * 72 + t] = f2bf(K.v[i]); }
        *(LAS u32x4*)(RT + t * 72 + dq * 8) = pack8(e1); *(LAS u32x4*)(BB + t * 72 + dq * 8) = pack8(e2); *(LAS u32x4*)(KB + t * 72 + dq * 8) = pack8(e3); *(LAS u32x4*)(RS + t * 72 + dq * 8) = pack8(e4);
    }
    LDS_BAR();
    {
        bf16x8 fa[2];
#pragma unroll
        for (int k = 0; k < 2; ++k) fa[k] = *(const LAS bf16x8*)(RT + (t0b + fr) * 72 + k * 32 + fq * 8);
#pragma unroll
        for (int sbi = 0; sbi < 2; ++sbi) { const int s0 = ((wave & 1) * 2 + sbi) * 16;
            f32x4 ab = (f32x4){0.f, 0.f, 0.f, 0.f}, ak = ab;
            if (s0 <= t0b + 15) {
#pragma unroll
                for (int k = 0; k < 2; ++k) { const bf16x8 fb = *(const LAS bf16x8*)(BB + (s0 + fr) * 72 + k * 32 + fq * 8), fk = *(const LAS bf16x8*)(KB + (s0 + fr) * 72 + k * 32 + fq * 8);
                    ab = __builtin_amdgcn_mfma_f32_16x16x32_bf16(fb, fa[k], ab, 0, 0, 0);
                    ak = __builtin_amdgcn_mfma_f32_16x16x32_bf16(fk, fa[k], ak, 0, 0, 0); }
            }
            float pb[4], pk[4];
#pragma unroll
            for (int j = 0; j < 4; ++j) { const bool m = (s0 + fq * 4 + j <= t0b + fr); pb[j] = m ? ab[j] : 0.f; pk[j] = m ? ak[j] : 0.f; }
            u32x2 o1, o2; o1.x = cvt_pk_bf16(pb[0], pb[1]); o1.y = cvt_pk_bf16(pb[2], pb[3]); o2.x = cvt_pk_bf16(pk[0], pk[1]); o2.y = cvt_pk_bf16(pk[2], pk[3]);
            *(LAS u32x2*)(RB + (t0b + fr) * 72 + s0 + fq * 4) = o1; *(LAS u32x2*)(RK + (t0b + fr) * 72 + s0 + fq * 4) = o2; }
        bf16x8 fw[2];
#pragma unroll
        for (int k = 0; k < 2; ++k) fw[k] = *(const LAS bf16x8*)(Wt + (t0b + fr) * 72 + k * 32 + fq * 8);
#pragma unroll
        for (int bi = 0; bi < 2; ++bi) { const int v0 = ((wave & 1) * 2 + bi) * 16; f32x4 acc;
#pragma unroll
            for (int j = 0; j < 4; ++j) acc[j] = u0v[bi][j];
#pragma unroll
            for (int k = 0; k < 2; ++k) { const bf16x8 fs = *(const LAS bf16x8*)(ST + (v0 + fr) * 72 + k * 32 + fq * 8); acc = __builtin_amdgcn_mfma_f32_16x16x32_bf16(fw[k], fs, acc, 0, 0, 0); }
            u32x2 o; o.x = cvt_pk_bf16(acc[0], acc[1]); o.y = cvt_pk_bf16(acc[2], acc[3]);
            *(LAS u32x2*)(UT + (v0 + fr) * 72 + t0b + fq * 4) = o; }
    }
    LDS_BAR();
    {
        bf16x8 f1[2], f2[2], f3[2];
#pragma unroll
        for (int k = 0; k < 2; ++k) { f1[k] = *(const LAS bf16x8*)(RS + (t0b + fr) * 72 + k * 32 + fq * 8); f2[k] = *(const LAS bf16x8*)(RB + (t0b + fr) * 72 + k * 32 + fq * 8); f3[k] = *(const LAS bf16x8*)(RK + (t0b + fr) * 72 + k * 32 + fq * 8); }
        const int tt = t0 + t0b + fr;
#pragma unroll
        for (int bi = 0; bi < 2; ++bi) { const int v0 = ((wave & 1) * 2 + bi) * 16; f32x4 acc = (f32x4){0.f, 0.f, 0.f, 0.f};
#pragma unroll
            for (int k = 0; k < 2; ++k) { const bf16x8 a1 = *(const LAS bf16x8*)(ST + (v0 + fr) * 72 + k * 32 + fq * 8), a2 = *(const LAS bf16x8*)(UT + (v0 + fr) * 72 + k * 32 + fq * 8), a3 = *(const LAS bf16x8*)(VT + (v0 + fr) * 72 + k * 32 + fq * 8);
                acc = __builtin_amdgcn_mfma_f32_16x16x32_bf16(a1, f1[k], acc, 0, 0, 0); acc = __builtin_amdgcn_mfma_f32_16x16x32_bf16(a2, f2[k], acc, 0, 0, 0); acc = __builtin_amdgcn_mfma_f32_16x16x32_bf16(a3, f3[k], acc, 0, 0, 0); }
            if (tt < T) { u32x2 o; o.x = cvt_pk_bf16(acc[0], acc[1]); o.y = cvt_pk_bf16(acc[2], acc[3]); *(u32x2*)(X.ORAW + ((size_t)b * T + tt) * 3072 + 2048 + h * 64 + v0 + fq * 4) = o; } }
    }
    LDS_BAR();
}

constexpr int MT = 16384;
template <int K>
__device__ __forceinline__ void skinny_partial(const bf16_t* A, const bf16_t* Bt, int c0, int wave, int fr, int fq, f32x4 (&acc)[2]) {
    constexpr int kw = K >> 3; const int k0 = wave * kw;
    acc[0] = (f32x4){0.f, 0.f, 0.f, 0.f}; acc[1] = acc[0];
#pragma unroll
    for (int k = 0; k < kw; k += 32) {
        const bf16x8 fb = *(const bf16x8*)(Bt + (size_t)(c0 + fr) * K + k0 + k + fq * 8);
        const bf16x8 a0 = *(const bf16x8*)(A + (size_t)fr * K + k0 + k + fq * 8), a1 = *(const bf16x8*)(A + (size_t)(16 + fr) * K + k0 + k + fq * 8);
        acc[0] = __builtin_amdgcn_mfma_f32_16x16x32_bf16(a0, fb, acc[0], 0, 0, 0);
        acc[1] = __builtin_amdgcn_mfma_f32_16x16x32_bf16(a1, fb, acc[1], 0, 0, 0);
    }
}
__device__ __forceinline__ f32x4 skinny_reduce(LAS float* red, const f32x4 (&acc)[2], int wave, int lane) {
    *(LAS f32x4*)(red + ((wave * 2 + 0) * 64 + lane) * 4) = acc[0]; *(LAS f32x4*)(red + ((wave * 2 + 1) * 64 + lane) * 4) = acc[1];
    __syncthreads();
    f32x4 s = (f32x4){0.f, 0.f, 0.f, 0.f};
    if (wave < 2) {
#pragma unroll
        for (int w = 0; w < 8; ++w) s += *(const LAS f32x4*)(red + ((w * 2 + wave) * 64 + lane) * 4);
    }
    __syncthreads();
    return s;
}
__device__ __forceinline__ void skinny_g2(LAS float* red, const bf16_t* Y, const bf16_t* WBRl, const bf16_t* PROJ, bf16_t* MERGED, int c0) {
    int tid = threadIdx.x; asm volatile("" : "+v"(tid));
    const int wave = tid >> 6, lane = tid & 63, fr = lane & 15, fq = lane >> 4;
    f32x4 tot = (f32x4){0.f, 0.f, 0.f, 0.f};
    for (int z = 0; z < 3; ++z) {
        f32x4 acc[2]; skinny_partial<1024>(Y + ((size_t)z * MP + MT) * 1024, WBRl + (size_t)z * D * 1024, c0, wave, fr, fq, acc);
        const f32x4 s = skinny_reduce(red, acc, wave, lane);
        if (wave < 2) {
#pragma unroll
            for (int j = 0; j < 4; ++j) { const int row = MT + wave * 16 + fq * 4 + j; tot[j] += s[j] * bf1(PROJ[(size_t)row * NP + C_G + z * 2048 + c0 + fr]); }
        }
    }
    if (wave < 2) {
#pragma unroll
        for (int j = 0; j < 4; ++j) { const int row = MT + wave * 16 + fq * 4 + j; MERGED[(size_t)row * D + c0 + fr] = f2bf(tot[j]); }
    }
}
__device__ __forceinline__ void skinny_g1b(LAS float* red, const bf16_t* ALR, const bf16_t* WLRl, const float* w0l, const float* a0l, bf16_t* CW, bf16_t* CA, int c0) {
    int tid = threadIdx.x; asm volatile("" : "+v"(tid));
    const int wave = tid >> 6, lane = tid & 63, fr = lane & 15, fq = lane >> 4;
    f32x4 acc[2]; skinny_partial<256>(ALR + (size_t)MT * 256, WLRl, c0, wave, fr, fq, acc);
    const f32x4 s = skinny_reduce(red, acc, wave, lane);
    if (wave < 2) {
        const int col = c0 + fr;
#pragma unroll
        for (int j = 0; j < 4; ++j) { const int row = MT + wave * 16 + fq * 4 + j;
            if (col < 1024) CW[(size_t)row * 1024 + col] = f2bf(-0.6065306597126334f * sigmoidf_(w0l[col] + s[j]));
            else CA[(size_t)row * 1024 + (col - 1024)] = f2bf(sigmoidf_(a0l[col - 1024] + s[j])); }
    }
}
__device__ __forceinline__ void skinny_g3(LAS float* red, const bf16_t* MERGED, const bf16_t* WOUTl, float* H, int c0) {
    int tid = threadIdx.x; asm volatile("" : "+v"(tid));
    const int wave = tid >> 6, lane = tid & 63, fr = lane & 15, fq = lane >> 4;
    f32x4 acc[2]; skinny_partial<D>(MERGED + (size_t)MT * D, WOUTl, c0, wave, fr, fq, acc);
    const f32x4 s = skinny_reduce(red, acc, wave, lane);
    if (wave < 2) {
#pragma unroll
        for (int j = 0; j < 4; ++j) { const int row = MT + wave * 16 + fq * 4 + j; H[(size_t)row * D + c0 + fr] += s[j]; }
    }
}

__global__ void __launch_bounds__(NTHREADS, 2) fwd_megakernel(Args args) {
    extern __shared__ __attribute__((aligned(16))) unsigned char lds_raw[];
    cg::grid_group grid = cg::this_grid();
    LAS unsigned char* lds = (LAS unsigned char*)lds_raw;
    LAS float* ldsf = (LAS float*)lds_raw;
    if (threadIdx.x == 0) { ((volatile LAS unsigned*)(lds + 131072))[0] = 0u; ((volatile LAS unsigned*)(lds + 131072))[1] = 0u; }
    __syncthreads();
    const XcdBarrier gbar = xcd_barrier_post((unsigned*)(args.ws + WS_BAR), (volatile LAS unsigned*)(lds + 131072));
    const int G = gridDim.x, NGW = G * NWAVES;
    const size_t GT = (size_t)G * NTHREADS;
#define PHASE_IDS int tid = threadIdx.x; asm volatile("" : "+v"(tid)); const int lane = tid & 63, wave = tid >> 6, gw = blockIdx.x * NWAVES + wave; const size_t gt = (size_t)blockIdx.x * NTHREADS + tid; (void)lane; (void)gw; (void)gt;
    unsigned char* ws = args.ws;
    const float* x = args.in[0]; const float* meta = args.in[1]; const float* norm_g = args.in[2]; const float* w_in = args.in[3];
    const float* lb_logits = args.in[4]; const float* hgrn_g = args.in[5]; const float* mconv = args.in[6]; const float* ig_b = args.in[7];
    const float* fg_b = args.in[8]; const float* mnorm_g = args.in[9]; const float* mu = args.in[10]; const float* w0 = args.in[11];
    const float* w_up = args.in[12]; const float* a0 = args.in[13]; const float* a_up = args.in[14]; const float* k_k = args.in[15];
    const float* k_a = args.in[16]; const float* r_k = args.in[17]; const float* ln_g = args.in[18]; const float* ln_b = args.in[19];
    const float* w_br = args.in[20]; const float* w_out = args.in[21]; const float* fin_g = args.in[22];
    bf16_t* WINT = (bf16_t*)(ws + WS_WINT); bf16_t* WBRT = (bf16_t*)(ws + WS_WBRT); bf16_t* WOUTT = (bf16_t*)(ws + WS_WOUTT); bf16_t* WLRT = (bf16_t*)(ws + WS_WLRT);
    float* LB = (float*)(ws + WS_LB); float* H = (float*)(ws + WS_H); bf16_t* XN = (bf16_t*)(ws + WS_XN); bf16_t* PROJ = (bf16_t*)(ws + WS_PROJ);
    float* AF = (float*)(ws + WS_AF); float* IGFG = (float*)(ws + WS_IGFG); bf16_t* BQK = (bf16_t*)(ws + WS_BQK); float* IL = (float*)(ws + WS_IL);
    bf16_t* CRKV = (bf16_t*)(ws + WS_CRKV); bf16_t* ALR = (bf16_t*)(ws + WS_ALR); bf16_t* CW = (bf16_t*)(ws + WS_CW); bf16_t* CA = (bf16_t*)(ws + WS_CA);
    bf16_t* ORAW = (bf16_t*)(ws + WS_ORAW); float* DEN = (float*)(ws + WS_DEN); float* MST = (float*)(ws + WS_MST); bf16_t* Y = (bf16_t*)(ws + WS_Y);
    float* MACC = (float*)(ws + WS_MACC); bf16_t* MERGED = (bf16_t*)(ws + WS_MERGED);

#ifndef NO_P0
    {
        PHASE_IDS
        constexpr int I_IN = 32 * 291, I_BR = 16 * 32, I_OUT = 32 * 32, I_LR = 16;
        constexpr int NITEMS = DEPTH * I_IN + DEPTH * 3 * I_BR + DEPTH * I_OUT + DEPTH * 2 * I_LR;
        for (int it = gw; it < NITEMS; it += NGW) {
            int r = it;
            if (r < DEPTH * I_IN) { const int l = r / I_IN; tr_item<true, false>(w_in + (size_t)l * D * NIN, NIN, WINT + (size_t)l * NP * D, D, 0, r % I_IN, lane); continue; }
            r -= DEPTH * I_IN;
            if (r < DEPTH * 3 * I_BR) { const int mi = r / I_BR; tr_item<false, false>(w_br + (size_t)mi * 1024 * D, D, WBRT + (size_t)mi * D * 1024, 1024, 0, r % I_BR, lane); continue; }
            r -= DEPTH * 3 * I_BR;
            if (r < DEPTH * I_OUT) { const int l = r / I_OUT; tr_item<false, false>(w_out + (size_t)l * D * D, D, WOUTT + (size_t)l * D * D, D, 0, r % I_OUT, lane); continue; }
            r -= DEPTH * I_OUT;
            { const int l = r / (2 * I_LR), q = r % (2 * I_LR);
              if (q < I_LR) tr_item<false, true>(w_up + (size_t)l * 64 * 1024, 1024, WLRT + (size_t)l * 2048 * 256, 256, 0, q, lane);
              else tr_item<false, true>(a_up + (size_t)l * 64 * 1024, 1024, WLRT + ((size_t)l * 2048 + 1024) * 256, 256, 64, q - I_LR, lane); }
        }
        for (size_t i = gt; i < (size_t)DEPTH * (NP - NIN) * D / 8; i += GT) { const size_t per = (size_t)(NP - NIN) * D / 8; const size_t l = i / per, o = i % per;
            *(u32x4*)(WINT + (l * NP + NIN) * D + o * 8) = (u32x4){0u, 0u, 0u, 0u}; }
        for (size_t i = gt; i < 1024; i += GT) { float e[4], mx = -1e30f, s = 0.f;
#pragma unroll
            for (int l = 0; l < 4; ++l) { e[l] = lb_logits[l * 1024 + i]; mx = fmaxf(mx, e[l]); }
#pragma unroll
            for (int l = 0; l < 4; ++l) { e[l] = expf(e[l] - mx); s += e[l]; }
            const float p1 = e[1] / s, p2 = e[2] / s, p3 = e[3] / s;
            LB[i] = 0.f; LB[1024 + i] = p1; LB[2048 + i] = p1 + p2; LB[3072 + i] = p1 + p2 + p3; }
        for (int r = gw; r < M; r += NGW) { const int b = r / T, t = r - b * T;
            const float* src = (t < NMETA) ? meta + (size_t)t * D : x + ((size_t)b * SEQ + (t - NMETA)) * D;
            rms_row(src, H + (size_t)r * D, norm_g, XN + (size_t)r * D, lane); }
        for (size_t i = gt; i < (size_t)(MP - M) * D / 8; i += GT) { *(u32x4*)(XN + (size_t)M * D + i * 8) = (u32x4){0u, 0u, 0u, 0u}; *(u32x4*)(MERGED + (size_t)M * D + i * 8) = (u32x4){0u, 0u, 0u, 0u}; }
        for (size_t i = gt; i < (size_t)(MP - M) * 256 / 8; i += GT) *(u32x4*)(ALR + (size_t)M * 256 + i * 8) = (u32x4){0u, 0u, 0u, 0u};
        for (size_t i = gt; i < (size_t)3 * (MP - M) * 1024 / 8; i += GT) { const size_t per = (size_t)(MP - M) * 1024 / 8; const size_t z = i / per, o = i % per;
            *(u32x4*)(Y + (z * MP + M) * 1024 + o * 8) = (u32x4){0u, 0u, 0u, 0u}; }
    }
#endif
    __syncthreads();
    grid.sync();

    for (int l = 0; l < DEPTH; ++l) {
        if (l > 0) {
            PHASE_IDS
            for (int r = gw; r < M; r += NGW) rms_row(H + (size_t)r * D, nullptr, norm_g + (size_t)l * D, XN + (size_t)r * D, lane);
            xcd_barrier(gbar);
        }
        {
            pg8::Gemm g{XN, WINT + (size_t)l * NP * D, MP, NP, D, 0, 0};
            pg8::Order S; S.init(MP, NP, 1, G, (int)blockIdx.x);
            EpiG1 E{PROJ, AF, IGFG, LB + l * 1024};
#ifndef NO_G1
            pg8::gemm_phase<EpiG1>(lds, g, S, E);
#endif
        }
        xcd_barrier(gbar);
#ifndef NO_R1
        { PHASE_IDS
#pragma unroll 2
        for (int r = gw; r < M; r += NGW) {
            const int b = r / T, t = r - b * T;
            const bf16_t* pr = PROJ + (size_t)r * NP;
#pragma unroll
            for (int it = 0; it < 2; ++it) {
                const int c8 = (it * 64 + lane) * 8;
                float o[8];
#pragma unroll
                for (int i = 0; i < 8; ++i) o[i] = 0.f;
#pragma unroll
                for (int j = 0; j < 4; ++j) {
                    if (t - 3 + j >= 0) {
                        float xv[8]; unpack8(*(const u32x4*)(pr - (size_t)(3 - j) * NP + C_BQ + c8), xv);
                        const float* wp = mconv + ((size_t)l * 4 + j) * 1024 + c8;
                        const f32x4 w0v = *(const f32x4*)wp, w1v = *(const f32x4*)(wp + 4);
#pragma unroll
                        for (int i = 0; i < 4; ++i) { o[i] += w0v[i] * xv[i]; o[4 + i] += w1v[i] * xv[4 + i]; }
                    }
                }
                const float sc = (c8 < 512) ? 0.08838834764831845f : 1.0f;
#pragma unroll
                for (int i = 0; i < 8; ++i) o[i] = siluf_(o[i]) * sc;
                *(u32x4*)(BQK + (size_t)r * 1024 + c8) = pack8(o);
            }
            if (lane < 8) {
                const float raw = IGFG[(size_t)r * 8 + lane];
                float o;
                if (lane < 4) o = raw + ig_b[l * 4 + lane];
                else { const float z = raw + fg_b[l * 4 + (lane - 4)]; o = fminf(z, 0.f) - __logf(1.0f + __expf(-fabsf(z))); }
                IL[(size_t)r * 8 + lane] = o;
            }
#pragma unroll
            for (int it = 0; it < 6; ++it) {
                const int c8 = (it * 64 + lane) * 8;
                float cur[8], prv[8], o[8];
                unpack8(*(const u32x4*)(pr + C_CR + c8), cur);
                if (t > 0) unpack8(*(const u32x4*)(pr - NP + C_CR + c8), prv);
                else {
#pragma unroll
                    for (int i = 0; i < 8; ++i) prv[i] = 0.f;
                }
                const float* mp = mu + (size_t)l * 3200 + c8;
                const f32x4 m0 = *(const f32x4*)mp, m1 = *(const f32x4*)(mp + 4);
#pragma unroll
                for (int i = 0; i < 4; ++i) { o[i] = cur[i] + (prv[i] - cur[i]) * m0[i]; o[4 + i] = cur[4 + i] + (prv[4 + i] - cur[4 + i]) * m1[i]; }
                *(u32x4*)(CRKV + (size_t)r * 3072 + c8) = pack8(o);
            }
            if (lane < 16) {
                const int c8 = lane * 8;
                float cur[8], prv[8], o[8];
                unpack8(*(const u32x4*)(pr + C_WD + c8), cur);
                if (t > 0) unpack8(*(const u32x4*)(pr - NP + C_WD + c8), prv);
                else {
#pragma unroll
                    for (int i = 0; i < 8; ++i) prv[i] = 0.f;
                }
                const float* mp = mu + (size_t)l * 3200 + 3072 + c8;
                const f32x4 m0 = *(const f32x4*)mp, m1 = *(const f32x4*)(mp + 4);
#pragma unroll
                for (int i = 0; i < 4; ++i) { o[i] = cur[i] + (prv[i] - cur[i]) * m0[i]; o[4 + i] = cur[4 + i] + (prv[4 + i] - cur[4 + i]) * m1[i]; }
                if (lane < 8) {
#pragma unroll
                    for (int i = 0; i < 8; ++i) o[i] = tanhf(o[i]);
                }
                *(u32x4*)(ALR + (size_t)r * 256 + c8) = pack8(o);
            } else if (lane < 32) {
                *(u32x4*)(ALR + (size_t)r * 256 + lane * 8) = (u32x4){0u, 0u, 0u, 0u};
            }
        } }
#endif
        xcd_barrier(gbar);
        {
            pg8::Gemm g{ALR, WLRT + (size_t)l * 2048 * 256, MT, 2048, 256, 0, 0};
            pg8::Order S; S.init(MT, 2048, 1, G, (int)blockIdx.x);
            EpiLR E{CW, CA, w0 + (size_t)l * 1024, a0 + (size_t)l * 1024};
#ifndef NO_G1B
            pg8::gemm_phase<EpiLR>(lds, g, S, E);
#endif
            for (int cb = (int)blockIdx.x; cb < 2048 / 16; cb += G) skinny_g1b(ldsf, ALR, WLRT + (size_t)l * 2048 * 256, w0 + (size_t)l * 1024, a0 + (size_t)l * 1024, CW, CA, cb * 16);
        }
        xcd_barrier(gbar);
        const LaCtx X{PROJ, AF, BQK, IL, (bf16_t*)(ws + WS_DSI), (bf16_t*)(ws + WS_DS), (float*)(ws + WS_DEC), (float*)(ws + WS_BEND), (float*)(ws + WS_MLOC), (float*)(ws + WS_MPREV), ORAW, DEN, MST};
        const RwCtx RX{CRKV, CW, CA, k_k + (size_t)l * 1024, k_a + (size_t)l * 1024, ws + WS_RWI, (bf16_t*)(ws + WS_SRW), ORAW};
#ifndef NO_RWA
        for (int it = (int)blockIdx.x; it < RW_ITEMS; it += G) rw_phaseA(lds, RX, it);
#endif
        for (int it = ((int)blockIdx.x + G - 32) % G; it < NITEMS_LA; it += G) la_phaseA(lds, X, it);
        xcd_barrier(gbar);
        la_scan(X);
#ifndef NO_RWB
        if ((int)blockIdx.x >= G - 32) rw_phaseB(lds, RX, (int)blockIdx.x - (G - 32));
#endif
        xcd_barrier(gbar);
#ifndef NO_RWC
        for (int it = (int)blockIdx.x; it < RW_ITEMS; it += G) rw_phaseC(lds, RX, it);
#endif
        for (int it = ((int)blockIdx.x + G - 32) % G; it < NITEMS_LA; it += G) la_phaseC(lds, X, it);
        xcd_barrier(gbar);
#ifndef NO_NORM
        { PHASE_IDS
        for (int r = gw; r < M; r += NGW) {
            const bf16_t* pr = PROJ + (size_t)r * NP;
            const int c0 = lane * 16;
            {
                float o[16]; float ss = 0.f;
#pragma unroll
                for (int j = 0; j < 2; ++j) { float t8[8]; unpack8(*(const u32x4*)(ORAW + (size_t)r * 3072 + c0 + 8 * j), t8);
#pragma unroll
                    for (int i = 0; i < 8; ++i) o[8 * j + i] = t8[i]; }
#pragma unroll
                for (int i = 0; i < 16; ++i) ss += o[i] * o[i];
                ss += __shfl_xor(ss, 1); ss += __shfl_xor(ss, 2); ss += __shfl_xor(ss, 4);
                const float rs = rsqrtf(ss * (1.0f / 128.0f) + 1e-6f);
#pragma unroll
                for (int hh = 0; hh < 2; ++hh) {
                    float z8[8], y8[8]; unpack8(*(const u32x4*)(pr + C_AZ + c0 + 8 * hh), z8);
#pragma unroll
                    for (int i = 0; i < 8; ++i) z8[i] = siluf_(z8[i]);
                    const float* gp = hgrn_g + (size_t)l * 1024 + c0 + 8 * hh;
#pragma unroll
                    for (int i = 0; i < 8; ++i) y8[i] = o[8 * hh + i] * rs * gp[i] * z8[i];
                    *(u32x4*)(Y + (size_t)r * 1024 + c0 + 8 * hh) = pack8(y8);
                }
            }
            {
                const int hd = lane >> 4;
                const float den = DEN[(size_t)r * 4 + hd], mm = MST[(size_t)r * 4 + hd];
                const float inv = 1.0f / fmaxf(fabsf(den), expf(-mm));
                float o[16]; float s1 = 0.f;
#pragma unroll
                for (int j = 0; j < 2; ++j) { float t8[8]; unpack8(*(const u32x4*)(ORAW + (size_t)r * 3072 + 1024 + c0 + 8 * j), t8);
#pragma unroll
                    for (int i = 0; i < 8; ++i) o[8 * j + i] = t8[i] * inv; }
#pragma unroll
                for (int i = 0; i < 16; ++i) s1 += o[i];
                s1 += __shfl_xor(s1, 1); s1 += __shfl_xor(s1, 2); s1 += __shfl_xor(s1, 4); s1 += __shfl_xor(s1, 8);
                const float mean = s1 * (1.0f / 256.0f);
                float s2 = 0.f;
#pragma unroll
                for (int i = 0; i < 16; ++i) { o[i] -= mean; s2 += o[i] * o[i]; }
                s2 += __shfl_xor(s2, 1); s2 += __shfl_xor(s2, 2); s2 += __shfl_xor(s2, 4); s2 += __shfl_xor(s2, 8);
                const float rs = rsqrtf(s2 * (1.0f / 256.0f) + 1e-6f);
#pragma unroll
                for (int hh = 0; hh < 2; ++hh) {
                    float og[8], z8[8], y8[8]; unpack8(*(const u32x4*)(pr + C_BO + c0 + 8 * hh), og); unpack8(*(const u32x4*)(pr + C_BZ + c0 + 8 * hh), z8);
#pragma unroll
                    for (int i = 0; i < 8; ++i) { og[i] = sigmoidf_(og[i]); z8[i] = siluf_(z8[i]); }
                    const float* gp = mnorm_g + (size_t)l * 1024 + c0 + 8 * hh;
#pragma unroll
                    for (int i = 0; i < 8; ++i) y8[i] = o[8 * hh + i] * rs * gp[i] * og[i] * z8[i];
                    *(u32x4*)(Y + ((size_t)MP + r) * 1024 + c0 + 8 * hh) = pack8(y8);
                }
            }
            {
                float o[16]; float s1 = 0.f;
#pragma unroll
                for (int j = 0; j < 2; ++j) { float t8[8]; unpack8(*(const u32x4*)(ORAW + (size_t)r * 3072 + 2048 + c0 + 8 * j), t8);
#pragma unroll
                    for (int i = 0; i < 8; ++i) o[8 * j + i] = t8[i]; }
#pragma unroll
                for (int i = 0; i < 16; ++i) s1 += o[i];
                s1 += __shfl_xor(s1, 1); s1 += __shfl_xor(s1, 2);
                const float mean = s1 * (1.0f / 64.0f);
                float s2 = 0.f;
#pragma unroll
                for (int i = 0; i < 16; ++i) { o[i] -= mean; s2 += o[i] * o[i]; }
                s2 += __shfl_xor(s2, 1); s2 += __shfl_xor(s2, 2);
                const float rs = rsqrtf(s2 * (1.0f / 64.0f) + 64e-5f);
                const bf16_t* cr = CRKV + (size_t)r * 3072;
                float rr[16], kk[16], vv[16];
#pragma unroll
                for (int hh = 0; hh < 2; ++hh) {
                    float t8[8];
                    unpack8(*(const u32x4*)(cr + c0 + 8 * hh), t8);
#pragma unroll
                    for (int i = 0; i < 8; ++i) rr[8 * hh + i] = t8[i];
                    unpack8(*(const u32x4*)(cr + 1024 + c0 + 8 * hh), t8);
#pragma unroll
                    for (int i = 0; i < 8; ++i) kk[8 * hh + i] = t8[i];
                    unpack8(*(const u32x4*)(cr + 2048 + c0 + 8 * hh), t8);
#pragma unroll
                    for (int i = 0; i < 8; ++i) vv[8 * hh + i] = t8[i];
                }
                float bs = 0.f;
#pragma unroll
                for (int i = 0; i < 16; ++i) { const float aa = bf1(CA[(size_t)r * 1024 + c0 + i]); const float kp = kk[i] * (1.0f + (aa - 1.0f) * k_a[(size_t)l * 1024 + c0 + i]);
                    bs += rr[i] * kp * r_k[(size_t)l * 1024 + c0 + i]; }
                bs += __shfl_xor(bs, 1); bs += __shfl_xor(bs, 2);
#pragma unroll
                for (int hh = 0; hh < 2; ++hh) {
                    float z8[8], y8[8]; unpack8(*(const u32x4*)(pr + C_CZ + c0 + 8 * hh), z8);
#pragma unroll
                    for (int i = 0; i < 8; ++i) z8[i] = siluf_(z8[i]);
                    const float* gp = ln_g + (size_t)l * 1024 + c0 + 8 * hh; const float* bp = ln_b + (size_t)l * 1024 + c0 + 8 * hh;
#pragma unroll
                    for (int i = 0; i < 8; ++i) y8[i] = (o[8 * hh + i] * rs * gp[i] + bp[i] + bs * vv[8 * hh + i]) * z8[i];
                    *(u32x4*)(Y + ((size_t)2 * MP + r) * 1024 + c0 + 8 * hh) = pack8(y8);
                }
            }
        } }
#endif
        xcd_barrier(gbar);
        {
            pg8::Gemm g{Y, WBRT + (size_t)l * 3 * D * 1024, MT, D, 1024, (size_t)MP * 1024 * 2, (size_t)D * 1024 * 2};
            pg8::Order S; S.init(MT, D, 3, G, (int)blockIdx.x);
            EpiG2 E{PROJ, MERGED};
#ifndef NO_G2
            pg8::gemm_phase<EpiG2>(lds, g, S, E);
#endif
            for (int cb = (int)blockIdx.x; cb < D / 16; cb += G) skinny_g2(ldsf, Y, WBRT + (size_t)l * 3 * D * 1024, PROJ, MERGED, cb * 16);
        }
        xcd_barrier(gbar);
        {
            pg8::Gemm g{MERGED, WOUTT + (size_t)l * D * D, MT, D, D, 0, 0};
            pg8::Order S; S.init(MT, D, 1, G, (int)blockIdx.x);
            EpiG3 E{H};
#ifndef NO_G3
            pg8::gemm_phase<EpiG3>(lds, g, S, E);
#endif
            for (int cb = (int)blockIdx.x; cb < D / 16; cb += G) skinny_g3(ldsf, MERGED, WOUTT + (size_t)l * D * D, H, cb * 16);
        }
        xcd_barrier(gbar);
    }
    PHASE_IDS
    for (int r = gw; r < M; r += NGW) {
        const int b = r / T, t = r - b * T;
        if (t < NMETA) continue;
        const float* src = H + (size_t)r * D;
        float* dst = args.out + ((size_t)b * SEQ + (t - NMETA)) * D;
        f32x4 v[8]; float ss = 0.f;
#pragma unroll
        for (int j = 0; j < 8; ++j) { v[j] = *(const f32x4*)(src + 256 * j + 4 * lane); ss += (v[j][0] * v[j][0] + v[j][1] * v[j][1]) + (v[j][2] * v[j][2] + v[j][3] * v[j][3]); }
        const float rs = rsqrtf(wave_sum(ss) * (1.0f / D) + 1e-6f);
#pragma unroll
        for (int j = 0; j < 8; ++j) { const f32x4 gg = *(const f32x4*)(fin_g + 256 * j + 4 * lane);
            *(f32x4*)(dst + 256 * j + 4 * lane) = (f32x4){v[j][0] * rs * gg[0], v[j][1] * rs * gg[1], v[j][2] * rs * gg[2], v[j][3] * rs * gg[3]}; }
    }
}

extern "C" void kernel_launch(void* const* d_in, const int* in_sizes, int n_in, void* d_out, int out_size, void* d_ws, size_t ws_size, hipStream_t stream) {
    static int grid = 0;
    if (grid == 0) {
        if (n_in != 23 || ws_size < WS_END) { fprintf(stderr, "kernel_launch: unexpected n_in %d or workspace %zu < %zu\n", n_in, ws_size, (size_t)WS_END); grid = -1; return; }
        int dev = 0, cus = 0, per_cu = 0;
        (void)hipGetDevice(&dev);
        (void)hipDeviceGetAttribute(&cus, hipDeviceAttributeMultiprocessorCount, dev);
        (void)hipFuncSetAttribute((const void*)fwd_megakernel, hipFuncAttributeMaxDynamicSharedMemorySize, LDS_BYTES);
        (void)hipOccupancyMaxActiveBlocksPerMultiprocessor(&per_cu, (const void*)fwd_megakernel, NTHREADS, LDS_BYTES);
        if (per_cu < 1) per_cu = 1;
        grid = cus * per_cu;
        fprintf(stderr, "kernel_launch: grid %d (cus %d x %d), ws %zu need %zu\n", grid, cus, per_cu, ws_size, (size_t)WS_END);
    }
    if (grid < 0) return;
    Args a{};
    for (int i = 0; i < 23; ++i) a.in[i] = (const float*)d_in[i];
    a.out = (float*)d_out; a.ws = (unsigned char*)d_ws;
    (void)hipMemsetAsync((unsigned char*)d_ws + WS_BAR, 0, (size_t)XCD_BAR_WORDS * 4, stream);
    void* kargs[] = {&a};
    hipError_t e = hipLaunchCooperativeKernel((const void*)fwd_megakernel, dim3(grid), dim3(NTHREADS), kargs, LDS_BYTES, stream);
    if (e != hipSuccess) fprintf(stderr, "kernel_launch: cooperative launch failed: %s (grid %d)\n", hipGetErrorString(e), grid);
}
```

```cpp
#include <hip/hip_runtime.h>
#include <hip/hip_cooperative_groups.h>
#include <cstdio>
namespace cg = cooperative_groups;

#define LAS __attribute__((address_space(3)))
typedef unsigned short bf16_t;
typedef short bf16x8 __attribute__((ext_vector_type(8)));
typedef float f32x4 __attribute__((ext_vector_type(4)));
typedef float f32x2 __attribute__((ext_vector_type(2)));
typedef unsigned u32x4 __attribute__((ext_vector_type(4)));
typedef unsigned u32x2 __attribute__((ext_vector_type(2)));

constexpr int D = 2048, NB = 2, SEQ = 8192, DEPTH = 4, NMETA = 16;
constexpr int T = SEQ + NMETA;
constexpr int M = NB * T;
constexpr int MP = 16640;
constexpr int NIN = 18568, NP = 18688;
constexpr int NTHREADS = 512, NWAVES = 8;
constexpr int C_AQ = 0, C_AF = 1024, C_AI = 2048, C_AZ = 3072, C_BQ = 4096, C_BK = 4608, C_BV = 5120, C_BO = 6144, C_BZ = 7168;
constexpr int C_CR = 8192, C_CK = 9216, C_CV = 10240, C_CZ = 11264, C_G = 12288, C_WD = 18432, C_AD = 18496, C_IG = 18560;

constexpr size_t al256(size_t x) { return (x + 255) & ~(size_t)255; }
constexpr size_t WS_WINT = 0;
constexpr size_t WS_WBRT = WS_WINT + al256((size_t)DEPTH * NP * D * 2);
constexpr size_t WS_WOUTT = WS_WBRT + al256((size_t)DEPTH * 3 * D * 1024 * 2);
constexpr size_t WS_WLRT = WS_WOUTT + al256((size_t)DEPTH * D * D * 2);
constexpr size_t WS_LB = WS_WLRT + al256((size_t)DEPTH * 2048 * 256 * 2);
constexpr size_t WS_H = WS_LB + al256((size_t)DEPTH * 1024 * 4);
constexpr size_t WS_XN = WS_H + al256((size_t)MP * D * 4);
constexpr size_t WS_PROJ = WS_XN + al256((size_t)MP * D * 2);
constexpr size_t WS_AF = WS_PROJ + al256((size_t)MP * NP * 2);
constexpr size_t WS_IGFG = WS_AF + al256((size_t)MP * 1024 * 4);
constexpr size_t WS_BQK = WS_IGFG + al256((size_t)MP * 8 * 4);
constexpr size_t WS_IL = WS_BQK + al256((size_t)MP * 1024 * 2);
constexpr size_t WS_CRKV = WS_IL + al256((size_t)MP * 8 * 4);
constexpr size_t WS_ALR = WS_CRKV + al256((size_t)MP * 3072 * 2);
constexpr size_t WS_CW = WS_ALR + al256((size_t)MP * 256 * 2);
constexpr size_t WS_CA = WS_CW + al256((size_t)MP * 1024 * 4);
constexpr size_t WS_ORAW = WS_CA + al256((size_t)MP * 1024 * 4);
constexpr size_t WS_DEN = WS_ORAW + al256((size_t)MP * 3072 * 4);
constexpr size_t WS_MST = WS_DEN + al256((size_t)MP * 4 * 4);
constexpr size_t WS_Y = WS_MST + al256((size_t)MP * 4 * 4);
constexpr size_t WS_MACC = WS_Y + al256((size_t)3 * MP * 1024 * 2);
constexpr size_t WS_MERGED = WS_MACC + al256((size_t)MP * D * 4);
constexpr size_t WS_RWI = WS_MACC;
constexpr size_t WS_SRW = WS_MACC + (size_t)32 * 129 * 33024;
constexpr size_t WS_DS = WS_MERGED + al256((size_t)MP * D * 2);
constexpr size_t WS_DSI = WS_DS + al256((size_t)32 * 129 * 129 * 128 * 2);
constexpr size_t WS_DEC = WS_DSI + al256((size_t)32 * 129 * 129 * 128 * 2);
constexpr size_t WS_BEND = WS_DEC + al256((size_t)16 * 129 * 128 * 4);
constexpr size_t WS_MLOC = WS_BEND + al256((size_t)8 * 129 * 4);
constexpr size_t WS_MPREV = WS_MLOC + al256((size_t)8 * 129 * 4);
constexpr size_t WS_BAR = WS_MPREV + al256((size_t)8 * 129 * 4);
constexpr size_t WS_END = WS_BAR + al256((size_t)3456 * 4);

constexpr int LDS_BYTES = 131072 + 64;

typedef __bf16 bf16x2_t __attribute__((ext_vector_type(2)));
__device__ __forceinline__ unsigned cvt_pk_bf16(float lo, float hi) { const bf16x2_t r = __builtin_convertvector((f32x2){lo, hi}, bf16x2_t); return __builtin_bit_cast(unsigned, r); }
__device__ __forceinline__ float bflo(unsigned u) { return __uint_as_float(u << 16); }
__device__ __forceinline__ float bfhi(unsigned u) { return __uint_as_float(u & 0xffff0000u); }
__device__ __forceinline__ float sigmoidf_(float x) { return __builtin_amdgcn_rcpf(1.0f + __expf(-x)); }
__device__ __forceinline__ float siluf_(float x) { return x * __builtin_amdgcn_rcpf(1.0f + __expf(-x)); }
__device__ __forceinline__ void unpack8(const u32x4 u, float (&f)[8]) {
    f[0] = bflo(u.x); f[1] = bfhi(u.x); f[2] = bflo(u.y); f[3] = bfhi(u.y); f[4] = bflo(u.z); f[5] = bfhi(u.z); f[6] = bflo(u.w); f[7] = bfhi(u.w);
}
__device__ __forceinline__ u32x4 pack8(const float (&f)[8]) {
    u32x4 o; o.x = cvt_pk_bf16(f[0], f[1]); o.y = cvt_pk_bf16(f[2], f[3]); o.z = cvt_pk_bf16(f[4], f[5]); o.w = cvt_pk_bf16(f[6], f[7]); return o;
}
template <int CTRL> __device__ __forceinline__ float dpp_f(float v) { return __int_as_float(__builtin_amdgcn_update_dpp(0, __float_as_int(v), CTRL, 0xf, 0xf, false)); }
__device__ __forceinline__ float row_sum16(float v) {
    v += dpp_f<0x128>(v);
    v += dpp_f<0x124>(v);
    v += dpp_f<0x122>(v);
    v += dpp_f<0x121>(v);
    return v;
}
__device__ __forceinline__ float wave_sum(float v) {
#pragma unroll
    for (int o = 1; o < 64; o <<= 1) v += __shfl_xor(v, o);
    return v;
}
#define LDS_WAIT() asm volatile("s_waitcnt lgkmcnt(0)" ::: "memory")
#define LDS_BAR() do { asm volatile("s_waitcnt lgkmcnt(0)" ::: "memory"); __builtin_amdgcn_s_barrier(); asm volatile("" ::: "memory"); } while (0)

#define XB_TMO      128
#define XB_XCNT(j)  (256  + 64 * (j))
#define XB_XSUB(j)  (1280 + 64 * (j))
#define XB_XGEN(j)  (2304 + 64 * (j))
#define XB_TOP      3328
#define XB_TOPGEN   3392
#define XCD_BAR_WORDS 3456
#define XB_SPIN_CAP (1u << 20)
__device__ __forceinline__ unsigned xb_ld(unsigned* p)              { return __hip_atomic_load(p, __ATOMIC_RELAXED, __HIP_MEMORY_SCOPE_AGENT); }
__device__ __forceinline__ unsigned xb_add(unsigned* p, unsigned v) { return __hip_atomic_fetch_add(p, v, __ATOMIC_RELAXED, __HIP_MEMORY_SCOPE_AGENT); }
__device__ __forceinline__ unsigned xb_xcc_id() { return (unsigned)__builtin_amdgcn_s_getreg((3 << 11) | 20) & 0xFu; }
#define XB_SPIN(cond, bar) do { unsigned _sp = 0; while (cond) { __builtin_amdgcn_s_sleep(1); \
    if ((++_sp & 255u) == 0u) { if (xb_ld(&(bar)[XB_TMO])) break; if (_sp > XB_SPIN_CAP) { atomicAdd(&(bar)[XB_TMO], 1u); break; } } } } while (0)
struct XcdBarrier { unsigned* bar; unsigned x; volatile LAS unsigned* st; };
__device__ __forceinline__ XcdBarrier xcd_barrier_post(unsigned* bar, volatile LAS unsigned* st) {
    XcdBarrier b; b.bar = bar; b.x = xb_xcc_id(); b.st = st;
    if (threadIdx.x == 0) (void)xb_add(&bar[XB_XCNT(b.x)], 1u);
    return b;
}
__device__ __forceinline__ void xcd_barrier_complete(unsigned* bar, unsigned x, unsigned& nloc, unsigned& nx) {
    const unsigned G = gridDim.x * gridDim.y * gridDim.z;
    unsigned sum, cnt, mine, sp = 0u;
    for (;;) {
        sum = 0u; cnt = 0u; mine = 0u;
#pragma unroll
        for (unsigned j = 0; j < 16; ++j) { const unsigned c = xb_ld(&bar[XB_XCNT(j)]); sum += c; cnt += (c > 0u) ? 1u : 0u; mine = (j == x) ? c : mine; }
        if (sum == G) break;
        __builtin_amdgcn_s_sleep(1);
        if ((++sp & 255u) == 0u) { if (xb_ld(&bar[XB_TMO])) break; if (sp > XB_SPIN_CAP) { atomicAdd(&bar[XB_TMO], 1u); break; } }
    }
    nloc = mine > 0u ? mine : 1u; nx = cnt > 0u ? cnt : 1u;
}
__device__ __forceinline__ void xcd_barrier(const XcdBarrier& b) {
    asm volatile("s_waitcnt vmcnt(0)" ::: "memory");
    __syncthreads();
    if (threadIdx.x == 0) {
        unsigned* bar = b.bar;
        __builtin_amdgcn_s_waitcnt(0);
        unsigned nloc = b.st[0], nx = b.st[1];
        if (nloc == 0u) { xcd_barrier_complete(bar, b.x, nloc, nx); b.st[0] = nloc; b.st[1] = nx; }
        const unsigned old = xb_add(&bar[XB_XSUB(b.x)], 1u);
        const unsigned gen = old / nloc;
        if (old + 1u == (gen + 1u) * nloc) {
            __builtin_amdgcn_fence(__ATOMIC_RELEASE, "agent");
            asm volatile("s_waitcnt vmcnt(0)" ::: "memory");
            const unsigned og = xb_add(&bar[XB_TOP], 1u);
            const unsigned tg = og / nx;
            if (og + 1u == (tg + 1u) * nx) xb_add(&bar[XB_TOPGEN], 1u);
            else XB_SPIN(xb_ld(&bar[XB_TOPGEN]) == tg, bar);
            __builtin_amdgcn_fence(__ATOMIC_ACQUIRE, "agent");
            xb_add(&bar[XB_XGEN(b.x)], 1u);
            asm volatile("s_waitcnt vmcnt(0)" ::: "memory");
        } else {
            XB_SPIN(xb_ld(&bar[XB_XGEN(b.x)]) == gen, bar);
            __builtin_amdgcn_fence(__ATOMIC_ACQUIRE, "agent");
            asm volatile("s_waitcnt vmcnt(0)" ::: "memory");
        }
    }
    __syncthreads();
}

namespace pg8 {
constexpr int BM = 256, BK = 64, HALF = 128, HTB = HALF * BK * 2, STAGE_BYTES = 8 * HTB, NXCD = 8, WGM = 8;
__device__ __forceinline__ int lds_byte(int r, int c) { const int st = (r >> 4) * 2 + (c >> 5), rr = r & 15, cc = c & 31, ob = rr * 64 + cc * 2; return st * 1024 + (ob ^ (((ob >> 9) & 1) << 5)); }
__device__ __forceinline__ void stage_rc(int b, int& R, int& C) { const int st = b / 1024, sb = b % 1024, swz = sb ^ (((sb >> 9) & 1) << 5); R = (st >> 1) * 16 + swz / 64; C = (st & 1) * 32 + (swz % 64) / 2; }
__device__ __forceinline__ int perm32(int rho) { const int n = rho >> 4, i = rho & 15; return 8 * (i >> 2) + 4 * n + (i & 3); }

struct Unit { int pm, pn, z; };
struct Gemm { const bf16_t* A; const bf16_t* Bt; int M, N, K; size_t zA, zB; };

struct Order {
    int nM, nN, nwg, G, c, nz;
    __device__ void init(int M_, int N_, int nz_, int G_, int c_) { nM = M_ / BM; nN = N_ / BM; nwg = nM * nN; G = G_; c = c_; nz = nz_; }
    __device__ bool next(int i, Unit& u) const {
        const int ti = i / nz; u.z = i - ti * nz;
        const long L = (long)ti * G + c; if (L >= nwg) return false;
        int wgid = (int)L; { const int q = nwg / NXCD, r = nwg % NXCD, xcd = wgid % NXCD, off = wgid / NXCD; wgid = (xcd < r ? xcd * (q + 1) : r * (q + 1) + (xcd - r) * q) + off; }
        const int nig = WGM * nN, gid = wgid / nig, fm = gid * WGM, gsz = (nM - fm) < WGM ? (nM - fm) : WGM;
        u.pm = fm + ((wgid % nig) % gsz); u.pn = (wgid % nig) / gsz; return true;
    }
};

template <class Epi>
__device__ __forceinline__ void gemm_phase(LAS unsigned char* lds, const Gemm g, const Order& S, const Epi& E) {
    int tid = threadIdx.x; asm volatile("" : "+v"(tid));
    const int wid = __builtin_amdgcn_readfirstlane(tid >> 6), lane = tid & 63, wr = wid >> 2, wc = wid & 3, fr = lane & 15, fq = lane >> 4;
    int K = g.K; asm volatile("" : "+s"(K));
    const int nt = K / BK;
    unsigned voffA[2], voffB[2];
#pragma unroll
    for (int i = 0; i < 2; ++i) { int R, C; stage_rc(tid * 16 + i * 8192, R, C); const int Rb = (R & ~31) + perm32(R & 31);
        voffA[i] = (unsigned)(R * K + C) * 2u; voffB[i] = (unsigned)(Rb * K + C) * 2u; }
    const size_t kstep = (size_t)(BK * 2);
    const size_t hstep = (size_t)HALF * K * 2;
    const size_t tstep = 2 * hstep;
    const unsigned ldsw = (unsigned)wid * 1024u;
    const int aoff = lds_byte(wr * 64 + fr, fq * 8), boff = lds_byte(wc * 32 + fr, fq * 8);
#define PG8_SA(b, h) (((b) * 2 + (h)) * HTB)
#define PG8_SB(b, h) ((4 + (b) * 2 + (h)) * HTB)
#define PG8_STAGE(bufoff, gbase, voff) do { _Pragma("unroll") for (int _i = 0; _i < 2; ++_i) \
        __builtin_amdgcn_global_load_lds((const unsigned*)((const char*)(gbase) + (voff)[_i]), (LAS unsigned*)(lds + (bufoff) + ldsw + _i * 8192), 16, 0, 0); } while (0)
#define PG8_LDA(dst, b, h) do { _Pragma("unroll") for (int m = 0; m < 4; ++m) _Pragma("unroll") for (int k = 0; k < 2; ++k) dst[m][k] = *(const LAS bf16x8*)(lds + PG8_SA(b, h) + aoff + m * 2048 + k * 1024); } while (0)
#define PG8_LDB(dst, b, h) do { _Pragma("unroll") for (int n = 0; n < 2; ++n) _Pragma("unroll") for (int k = 0; k < 2; ++k) dst[n][k] = *(const LAS bf16x8*)(lds + PG8_SB(b, h) + boff + n * 2048 + k * 1024); } while (0)
#define PG8_MMA(ai, bj, At, Bt) do { __builtin_amdgcn_s_setprio(1); _Pragma("unroll") for (int m = 0; m < 4; ++m) _Pragma("unroll") for (int n = 0; n < 2; ++n) _Pragma("unroll") for (int k = 0; k < 2; ++k) \
        acc[ai][bj][m][n] = __builtin_amdgcn_mfma_f32_16x16x32_bf16(Bt[n][k], At[m][k], acc[ai][bj][m][n], 0, 0, 0); __builtin_amdgcn_s_setprio(0); } while (0)
#define PG8_WAIT_V(n) asm volatile("s_waitcnt vmcnt(" #n ")" ::: "memory")
#define PG8_WAIT_L(n) asm volatile("s_waitcnt lgkmcnt(" #n ")" ::: "memory")
#define PG8_BAR __builtin_amdgcn_s_barrier()
#define PG8_SCHED __builtin_amdgcn_sched_barrier(0)
    Unit cur, nxt; int ui = 0;
    if (!S.next(0, cur)) return;
    f32x4 acc[2][2][4][2];
#pragma unroll
    for (int a = 0; a < 2; ++a)
#pragma unroll
        for (int b = 0; b < 2; ++b)
#pragma unroll
            for (int m = 0; m < 4; ++m)
#pragma unroll
                for (int n = 0; n < 2; ++n) acc[a][b][m][n] = (f32x4){0.f, 0.f, 0.f, 0.f};
    bf16x8 At[4][2], B0[2][2], B1[2][2];
    const char* cA = (const char*)g.A + (size_t)cur.z * g.zA + (size_t)cur.pm * tstep; const char* cB = (const char*)g.Bt + (size_t)cur.z * g.zB + (size_t)cur.pn * tstep;
    PG8_STAGE(PG8_SB(0, 0), cB, voffB); PG8_STAGE(PG8_SB(0, 1), cB + hstep, voffB); PG8_STAGE(PG8_SA(0, 0), cA, voffA); PG8_STAGE(PG8_SA(0, 1), cA + hstep, voffA);
    if (wr == 1) PG8_BAR;
    PG8_WAIT_V(2); PG8_BAR;
    PG8_STAGE(PG8_SB(1, 0), cB + kstep, voffB); PG8_STAGE(PG8_SA(1, 0), cA + kstep, voffA); PG8_STAGE(PG8_SB(1, 1), cB + hstep + kstep, voffB);
    PG8_WAIT_V(6); PG8_BAR;
    for (;;) {
        const bool has_next = S.next(ui + 1, nxt);
        const char* nA = has_next ? (const char*)g.A + (size_t)nxt.z * g.zA + (size_t)nxt.pm * tstep : cA; const char* nB = has_next ? (const char*)g.Bt + (size_t)nxt.z * g.zB + (size_t)nxt.pn * tstep : cB;
        for (int t = 0; t < nt; t += 2) {
            const bool last = (t == nt - 2);
            const char* a1 = cA + (size_t)(t + 1) * kstep;
            const char* a2 = last ? nA : cA + (size_t)(t + 2) * kstep; const char* b2 = last ? nB : cB + (size_t)(t + 2) * kstep;
            const char* a3 = a2 + kstep; const char* b3 = b2 + kstep;
            PG8_LDB(B0, 0, 0); PG8_LDB(B1, 0, 1); PG8_SCHED; PG8_LDA(At, 0, 0); PG8_STAGE(PG8_SA(1, 1), a1 + hstep, voffA);
            PG8_WAIT_V(8); PG8_WAIT_L(0); PG8_BAR; PG8_MMA(0, 0, At, B0); PG8_MMA(0, 1, At, B1); PG8_BAR; PG8_SCHED;
            PG8_LDA(At, 0, 1); PG8_STAGE(PG8_SB(0, 0), b2, voffB); PG8_STAGE(PG8_SB(0, 1), b2 + hstep, voffB); PG8_STAGE(PG8_SA(0, 0), a2, voffA);
            PG8_WAIT_V(8); PG8_WAIT_L(0); PG8_BAR; PG8_MMA(1, 0, At, B0); PG8_MMA(1, 1, At, B1); PG8_BAR; PG8_SCHED;
            PG8_LDB(B0, 1, 0); PG8_LDB(B1, 1, 1); PG8_SCHED; PG8_LDA(At, 1, 0); PG8_STAGE(PG8_SA(0, 1), a2 + hstep, voffA);
            PG8_WAIT_V(8); PG8_WAIT_L(0); PG8_BAR; PG8_MMA(0, 0, At, B0); PG8_MMA(0, 1, At, B1); PG8_BAR; PG8_SCHED;
            PG8_LDA(At, 1, 1); PG8_STAGE(PG8_SB(1, 0), b3, voffB); PG8_STAGE(PG8_SB(1, 1), b3 + hstep, voffB); PG8_STAGE(PG8_SA(1, 0), a3, voffA);
            PG8_WAIT_V(8); PG8_WAIT_L(0); PG8_BAR; PG8_MMA(1, 0, At, B0); PG8_MMA(1, 1, At, B1); PG8_BAR; PG8_SCHED;
        }
        if (wr == 0) PG8_BAR;
        E(acc, cur, wr, wc, fr, fq);
        if (!has_next) break;
#pragma unroll
        for (int a = 0; a < 2; ++a)
#pragma unroll
            for (int b = 0; b < 2; ++b)
#pragma unroll
                for (int m = 0; m < 4; ++m)
#pragma unroll
                    for (int n = 0; n < 2; ++n) acc[a][b][m][n] = (f32x4){0.f, 0.f, 0.f, 0.f};
        cur = nxt; cA = nA; cB = nB; ++ui;
        if (wr == 1) PG8_BAR;
    }
    PG8_WAIT_V(0);
    PG8_BAR;
#undef PG8_SA
#undef PG8_SB
#undef PG8_STAGE
#undef PG8_LDA
#undef PG8_LDB
#undef PG8_MMA
#undef PG8_WAIT_V
#undef PG8_WAIT_L
#undef PG8_BAR
#undef PG8_SCHED
}
}

#define EPI_LOOP_BEGIN \
    const int row0 = u.pm * 256 + wr * 64 + fr, col0 = u.pn * 256 + wc * 32 + 8 * fq; \
    _Pragma("unroll") for (int ai = 0; ai < 2; ++ai) _Pragma("unroll") for (int m = 0; m < 4; ++m) { const int row = row0 + ai * 128 + m * 16; \
        _Pragma("unroll") for (int bj = 0; bj < 2; ++bj) { const int col = col0 + bj * 128; const f32x4 _c0 = acc[ai][bj][m][0], _c1 = acc[ai][bj][m][1]; \
            float v[8] = {_c0[0], _c0[1], _c0[2], _c0[3], _c1[0], _c1[1], _c1[2], _c1[3]};
#define EPI_LOOP_END } }

struct EpiG1 {
    bf16_t* PROJ; float* AF; float* IGFG; const float* LBl;
    __device__ __forceinline__ void operator()(const f32x4 (&acc)[2][2][4][2], const pg8::Unit& u, int wr, int wc, int fr, int fq) const {
        const int pn = u.pn;
        int kind;
        if (pn < 4) kind = 3; else if (pn < 8) kind = 4; else if (pn < 48) kind = 0; else if (pn < 72) kind = 2; else kind = 5;
        EPI_LOOP_BEGIN
            if (kind == 1) {
#pragma unroll
                for (int i = 0; i < 8; ++i) v[i] = siluf_(v[i]);
            } else if (kind == 2) {
#pragma unroll
                for (int i = 0; i < 8; ++i) v[i] = sigmoidf_(v[i]);
            } else if (kind == 3) {
#pragma unroll
                for (int i = 0; i < 8; ++i) v[i] = siluf_(v[i]) * 0.08838834764831845f;
            } else if (kind == 4) {
                const int c = col - C_AF;
                const f32x4 l0 = *(const f32x4*)(LBl + c), l1 = *(const f32x4*)(LBl + c + 4);
                const float lb[8] = {l0[0], l0[1], l0[2], l0[3], l1[0], l1[1], l1[2], l1[3]};
                float f[8];
#pragma unroll
                for (int i = 0; i < 8; ++i) { const float s = sigmoidf_(v[i]); f[i] = logf(fmaxf(lb[i] + (1.0f - lb[i]) * s, 1e-12f)); v[i] = (1.0f - lb[i]) * (1.0f - s); }
                float* fp = AF + (size_t)row * 1024 + c;
                *(f32x4*)fp = (f32x4){f[0], f[1], f[2], f[3]}; *(f32x4*)(fp + 4) = (f32x4){f[4], f[5], f[6], f[7]};
            } else if (kind == 5) {
                if (col == C_IG) { float* fp = IGFG + (size_t)row * 8; *(f32x4*)fp = (f32x4){v[0], v[1], v[2], v[3]}; *(f32x4*)(fp + 4) = (f32x4){v[4], v[5], v[6], v[7]}; }
            }
            *(u32x4*)(PROJ + (size_t)row * NP + col) = pack8(v);
        EPI_LOOP_END
    }
};
struct EpiLR {
    bf16_t* CW; bf16_t* CA; const float* w0; const float* a0;
    __device__ __forceinline__ void operator()(const f32x4 (&acc)[2][2][4][2], const pg8::Unit& u, int wr, int wc, int fr, int fq) const {
        const bool isw = u.pn < 4;
        const float* pb = isw ? w0 : a0 - 1024;
        bf16_t* ob = isw ? CW : CA - 1024;
        EPI_LOOP_BEGIN
            const f32x4 p0 = *(const f32x4*)(pb + col), p1 = *(const f32x4*)(pb + col + 4);
            const float p[8] = {p0[0], p0[1], p0[2], p0[3], p1[0], p1[1], p1[2], p1[3]};
            float o[8];
#pragma unroll
            for (int i = 0; i < 8; ++i) { o[i] = sigmoidf_(p[i] + v[i]); if (isw) o[i] = -0.6065306597126334f * o[i]; }
            *(u32x4*)(ob + (size_t)row * 1024 + col) = pack8(o);
            __builtin_amdgcn_sched_barrier(0);
        EPI_LOOP_END
    }
};
struct EpiG2 {
    const bf16_t* PROJ; bf16_t* MERGED;
    __device__ __forceinline__ void operator()(const f32x4 (&acc)[2][2][4][2], const pg8::Unit& u, int wr, int wc, int fr, int fq) const {
        const int z = u.z;
        EPI_LOOP_BEGIN
            float g[8]; unpack8(*(const u32x4*)(PROJ + (size_t)row * NP + C_G + z * 2048 + col), g);
            bf16_t* mp = MERGED + (size_t)row * D + col;
            if (z == 0) {
#pragma unroll
                for (int i = 0; i < 8; ++i) v[i] *= g[i];
            } else {
                float mm[8]; unpack8(*(const u32x4*)mp, mm);
#pragma unroll
                for (int i = 0; i < 8; ++i) v[i] = mm[i] + v[i] * g[i];
            }
            *(u32x4*)mp = pack8(v);
        EPI_LOOP_END
    }
};
struct EpiG3 {
    float* H;
    __device__ __forceinline__ void operator()(const f32x4 (&acc)[2][2][4][2], const pg8::Unit& u, int wr, int wc, int fr, int fq) const {
        EPI_LOOP_BEGIN
            float* hp = H + (size_t)row * D + col;
            const f32x4 h0 = *(const f32x4*)hp, h1 = *(const f32x4*)(hp + 4);
            *(f32x4*)hp = (f32x4){h0[0] + v[0], h0[1] + v[1], h0[2] + v[2], h0[3] + v[3]};
            *(f32x4*)(hp + 4) = (f32x4){h1[0] + v[4], h1[1] + v[5], h1[2] + v[6], h1[3] + v[7]};
        EPI_LOOP_END
    }
};

__device__ __forceinline__ int win_dest_row(int c) {
    if (c < 7168) return c;
    if (c < 7176) return C_IG + (c - 7168);
    if (c < 11272) return c - 8;
    if (c < 11400) return C_WD + (c - 11272);
    return c - 136;
}
template <bool WIN>
__device__ __forceinline__ void transpose_item(const float* W, int K, int N, bf16_t* WT, LAS float* scr, int item, int lane) {
    const int nblk = (N + 31) / 32, kb = item / nblk, nb = item % nblk, k0 = 64 * kb, n0 = 32 * nb;
    const int nn = n0 + (lane & 31);
#pragma unroll 8
    for (int i = 0; i < 32; ++i) { const int kk = 2 * i + (lane >> 5); scr[kk * 33 + (lane & 31)] = (nn < N) ? W[(size_t)(k0 + kk) * N + nn] : 0.f; }
    LDS_WAIT();
    const int c = lane & 7;
#pragma unroll
    for (int j = 0; j < 4; ++j) { const int n = (lane >> 3) + 8 * j; const LAS float* s = scr + (8 * c) * 33 + n;
        u32x4 o; o.x = cvt_pk_bf16(s[0 * 33], s[1 * 33]); o.y = cvt_pk_bf16(s[2 * 33], s[3 * 33]); o.z = cvt_pk_bf16(s[4 * 33], s[5 * 33]); o.w = cvt_pk_bf16(s[6 * 33], s[7 * 33]);
        if (n0 + n < N) { const int dr = WIN ? win_dest_row(n0 + n) : (n0 + n); *(u32x4*)(WT + (size_t)dr * K + k0 + 8 * c) = o; } }
    LDS_WAIT();
}

template <bool WIN, bool ZF>
__device__ __forceinline__ void tr_item(const float* W, int N, bf16_t* WT, int ldt, int kcol0, int item, int lane) {
    const int nblk = (N + 63) / 64, kb = item / nblk, nb = item - kb * nblk, k0 = 64 * kb, n = 64 * nb + lane;
    if (n >= N) return;
    float x[64];
#pragma unroll
    for (int i = 0; i < 64; ++i) x[i] = W[(size_t)(k0 + i) * N + n];
    const int dr = WIN ? win_dest_row(n) : n;
    bf16_t* row = WT + (size_t)dr * ldt;
#pragma unroll
    for (int g = 0; g < 8; ++g) { u32x4 o; o.x = cvt_pk_bf16(x[8 * g], x[8 * g + 1]); o.y = cvt_pk_bf16(x[8 * g + 2], x[8 * g + 3]); o.z = cvt_pk_bf16(x[8 * g + 4], x[8 * g + 5]); o.w = cvt_pk_bf16(x[8 * g + 6], x[8 * g + 7]);
        *(u32x4*)(row + kcol0 + k0 + 8 * g) = o; }
    if (ZF) {
#pragma unroll
        for (int g = 0; g < 32; ++g) if (g * 8 < kcol0 || g * 8 >= kcol0 + 64) *(u32x4*)(row + 8 * g) = (u32x4){0u, 0u, 0u, 0u};
    }
}

__device__ __forceinline__ void rms_row(const float* src, float* Hrow, const float* g, bf16_t* xn, int lane) {
    f32x4 v[8]; float ss = 0.f;
#pragma unroll
    for (int j = 0; j < 8; ++j) { v[j] = *(const f32x4*)(src + 256 * j + 4 * lane); ss += (v[j][0] * v[j][0] + v[j][1] * v[j][1]) + (v[j][2] * v[j][2] + v[j][3] * v[j][3]); }
    if (Hrow) {
#pragma unroll
        for (int j = 0; j < 8; ++j) *(f32x4*)(Hrow + 256 * j + 4 * lane) = v[j];
    }
    const float rs = rsqrtf(wave_sum(ss) * (1.0f / D) + 1e-6f);
#pragma unroll
    for (int j = 0; j < 8; ++j) { const f32x4 gg = *(const f32x4*)(g + 256 * j + 4 * lane);
        u32x2 o; o.x = cvt_pk_bf16(v[j][0] * rs * gg[0], v[j][1] * rs * gg[1]); o.y = cvt_pk_bf16(v[j][2] * rs * gg[2], v[j][3] * rs * gg[3]);
        *(u32x2*)(xn + 256 * j + 4 * lane) = o; }
}

struct Args { const float* in[23]; float* out; unsigned char* ws; };

constexpr int TB = 32, NBLK = (T + TB - 1) / TB;
constexpr int ST_FLOATS = 13312;
constexpr int OB_OFF = 2 * ST_FLOATS;
constexpr int MB_OFF = OB_OFF + 2 * 1024;

constexpr int NCH = 129, NSTREAM = 32, ITEM_ELEMS = 129 * 128, NITEMS_LA = NSTREAM * NCH;
constexpr int L_QA = 0, L_KB = 17408, L_QC = 34816, L_VT = 52224, L_ST = 70656, L_PB = 105472, L_SC = 114688;
constexpr int LDQ = 136, LDT = 72;
struct LaCtx { const bf16_t* PROJ; const float* AF; const bf16_t* BQK; const float* IL; bf16_t* DSI; bf16_t* DS; float* DEC; float* BEND; float* MLOC; float* MPREV; bf16_t* ORAW; float* DEN; float* MST; };
__device__ __forceinline__ bf16_t f2bf(float x) { return (bf16_t)(cvt_pk_bf16(x, 0.f) & 0xffffu); }
__device__ __forceinline__ float bf1(bf16_t b) { return __uint_as_float(((unsigned)b) << 16); }

__device__ __forceinline__ void la_phaseA(LAS unsigned char* lds, const LaCtx& X, int item) {
    int tid = threadIdx.x; asm volatile("" : "+v"(tid));
    const int wave = tid >> 6, lane = tid & 63, seg = tid >> 7, ch = tid & 127, fr = lane & 15, fq = lane >> 4;
    const int s = item / NCH, c = item - s * NCH, t0 = c * 64, mode = s >> 4;
    LAS bf16_t* KT = (LAS bf16_t*)(lds + L_QA);
    LAS bf16_t* VT = (LAS bf16_t*)(lds + L_VT);
    LAS float* SC = (LAS float*)(lds + L_SC);
    bf16_t* dsb = X.DSI + (size_t)item * ITEM_ELEMS;
    float kf[16]; bf16_t vr[16];
    if (mode == 0) {
        const int b = s >> 3, h = s & 7; const size_t rowbase = (size_t)b * T;
        float cs[16]; float run = 0.f;
#pragma unroll
        for (int i = 0; i < 16; ++i) { const int tt = t0 + seg * 16 + i; const bool ok = tt < T; const size_t row = rowbase + (ok ? tt : 0);
            const float lf = ok ? X.AF[row * 1024 + h * 128 + ch] : 0.f; run += lf; cs[i] = run;
            kf[i] = ok ? bf1(X.PROJ[row * NP + C_AF + h * 128 + ch]) : 0.f; vr[i] = ok ? X.PROJ[row * NP + C_AI + h * 128 + ch] : (bf16_t)0; }
        SC[seg * 128 + ch] = run;
        LDS_BAR();
        float off = 0.f, tot = 0.f;
#pragma unroll
        for (int s2 = 0; s2 < 4; ++s2) { const float x = SC[s2 * 128 + ch]; if (s2 < seg) off += x; tot += x; }
#pragma unroll
        for (int i = 0; i < 16; ++i) kf[i] *= __expf(tot - (off + cs[i]));
        if (seg == 0) X.DEC[((size_t)s * NCH + c) * 128 + ch] = __expf(tot);
    } else {
        const int bhm = (s - 16) >> 1, vhalf = (s - 16) & 1, b = bhm >> 2, h = bhm & 3; const size_t rowbase = (size_t)b * T;
#pragma unroll
        for (int i = 0; i < 16; ++i) { const int tt = t0 + seg * 16 + i; const bool ok = tt < T; const size_t row = rowbase + (ok ? tt : 0);
            kf[i] = ok ? bf1(X.BQK[row * 1024 + 512 + h * 128 + ch]) : 0.f;
            vr[i] = ok ? X.PROJ[row * NP + C_BV + h * 256 + vhalf * 128 + ch] : (bf16_t)0; }
        if (wave == 0) {
            const int tt = t0 + lane; const bool ok = tt < T; const size_t row = rowbase + (ok ? tt : 0);
            const float lfv = ok ? X.IL[row * 8 + 4 + h] : 0.f, igv = ok ? X.IL[row * 8 + h] : -1e30f;
            float bcs = lfv;
#pragma unroll
            for (int o = 1; o < 64; o <<= 1) { const float x = __shfl_up(bcs, o); if (lane >= o) bcs += x; }
            const float g = ok ? igv - bcs : -1e30f;
            float gm = g;
#pragma unroll
            for (int o = 1; o < 64; o <<= 1) gm = fmaxf(gm, __shfl_xor(gm, o));
            const float bend = __shfl(bcs, 63);
            SC[1024 + lane] = __expf(g - gm);
            if (lane == 0 && vhalf == 0) { X.BEND[bhm * NCH + c] = bend; X.MLOC[bhm * NCH + c] = bend + gm; }
        }
        LDS_BAR();
        float pn = 0.f;
#pragma unroll
        for (int i = 0; i < 16; ++i) { kf[i] *= SC[1024 + seg * 16 + i]; pn += kf[i]; }
        SC[512 + seg * 128 + ch] = pn;
    }
    {
        u32x4 k0, k1, v0, v1;
        k0.x = cvt_pk_bf16(kf[0], kf[1]); k0.y = cvt_pk_bf16(kf[2], kf[3]); k0.z = cvt_pk_bf16(kf[4], kf[5]); k0.w = cvt_pk_bf16(kf[6], kf[7]);
        k1.x = cvt_pk_bf16(kf[8], kf[9]); k1.y = cvt_pk_bf16(kf[10], kf[11]); k1.z = cvt_pk_bf16(kf[12], kf[13]); k1.w = cvt_pk_bf16(kf[14], kf[15]);
        v0.x = vr[0] | ((unsigned)vr[1] << 16); v0.y = vr[2] | ((unsigned)vr[3] << 16); v0.z = vr[4] | ((unsigned)vr[5] << 16); v0.w = vr[6] | ((unsigned)vr[7] << 16);
        v1.x = vr[8] | ((unsigned)vr[9] << 16); v1.y = vr[10] | ((unsigned)vr[11] << 16); v1.z = vr[12] | ((unsigned)vr[13] << 16); v1.w = vr[14] | ((unsigned)vr[15] << 16);
        *(LAS u32x4*)(KT + ch * LDT + seg * 16) = k0; *(LAS u32x4*)(KT + ch * LDT + seg * 16 + 8) = k1;
        *(LAS u32x4*)(VT + ch * LDT + seg * 16) = v0; *(LAS u32x4*)(VT + ch * LDT + seg * 16 + 8) = v1;
    }
    LDS_BAR();
    if (mode == 1 && seg == 0) dsb[128 * 128 + ch] = f2bf((SC[512 + ch] + SC[640 + ch]) + (SC[768 + ch] + SC[896 + ch]));
    {
        const int v0 = wave * 16;
        bf16x8 bv[2];
#pragma unroll
        for (int k = 0; k < 2; ++k) bv[k] = *(const LAS bf16x8*)(VT + (v0 + fr) * LDT + k * 32 + fq * 8);
#pragma unroll
        for (int nb = 0; nb < 8; ++nb) { const int d0 = nb * 16; f32x4 acc = (f32x4){0.f, 0.f, 0.f, 0.f};
#pragma unroll
            for (int k = 0; k < 2; ++k) { const bf16x8 a = *(const LAS bf16x8*)(KT + (d0 + fr) * LDT + k * 32 + fq * 8); acc = __builtin_amdgcn_mfma_f32_16x16x32_bf16(a, bv[k], acc, 0, 0, 0); }
            u32x2 o; o.x = cvt_pk_bf16(acc[0], acc[1]); o.y = cvt_pk_bf16(acc[2], acc[3]);
            *(u32x2*)(dsb + (size_t)(v0 + fr) * 128 + d0 + fq * 4) = o; }
    }
    LDS_BAR();
}

__device__ __forceinline__ void la_scan(const LaCtx& X) {
    int tid = threadIdx.x; asm volatile("" : "+v"(tid));
    const int task = blockIdx.x * NTHREADS + tid;
    if (task >= NSTREAM * 2064) return;
    const int s = task / 2064, rem = task - s * 2064, row = rem >> 4, d8 = (rem & 15) * 8, mode = s >> 4;
    if (mode == 0 && row == 128) return;
    bf16_t* base = X.DS + (size_t)s * NCH * ITEM_ELEMS + row * 128 + d8;
    const bf16_t* ibase = X.DSI + (size_t)s * NCH * ITEM_ELEMS + row * 128 + d8;
    const float* decb = X.DEC + (size_t)(s & 15) * NCH * 128 + d8;
    const int bhm = (s & 15) >> 1; const bool wr_m = (mode == 1) && ((s & 1) == 0) && (rem == 0);
    const float* bendp = X.BEND + bhm * NCH; const float* mlocp = X.MLOC + bhm * NCH;
    float S[8];
#pragma unroll
    for (int i = 0; i < 8; ++i) S[i] = 0.f;
    float m = 0.f;
    u32x4 x[4], y[4]; f32x4 da[4], db[4], ea[4], eb[4]; float be[4], ml[4], be2[4], ml2[4];
#pragma unroll
    for (int j = 0; j < 4; ++j) { x[j] = *(const u32x4*)(ibase + (size_t)j * ITEM_ELEMS);
        if (mode == 0) { da[j] = *(const f32x4*)(decb + j * 128); db[j] = *(const f32x4*)(decb + j * 128 + 4); be[j] = 0.f; ml[j] = 0.f; }
        else { be[j] = bendp[j]; ml[j] = mlocp[j]; da[j] = (f32x4){0.f, 0.f, 0.f, 0.f}; db[j] = da[j]; } }
    for (int c0 = 0; c0 < NCH; c0 += 4) {
#pragma unroll
        for (int j = 0; j < 4; ++j) { const int cn = c0 + 4 + j;
            if (cn < NCH) { y[j] = *(const u32x4*)(ibase + (size_t)cn * ITEM_ELEMS);
                if (mode == 0) { ea[j] = *(const f32x4*)(decb + cn * 128); eb[j] = *(const f32x4*)(decb + cn * 128 + 4); be2[j] = 0.f; ml2[j] = 0.f; }
                else { be2[j] = bendp[cn]; ml2[j] = mlocp[cn]; ea[j] = (f32x4){0.f, 0.f, 0.f, 0.f}; eb[j] = ea[j]; } }
            else { y[j] = (u32x4){0u, 0u, 0u, 0u}; ea[j] = (f32x4){0.f, 0.f, 0.f, 0.f}; eb[j] = ea[j]; be2[j] = 0.f; ml2[j] = 0.f; } }
#pragma unroll
        for (int j = 0; j < 4; ++j) { const int c = c0 + j;
            if (c < NCH) {
                *(u32x4*)(base + (size_t)c * ITEM_ELEMS) = pack8(S);
                float xv[8]; unpack8(x[j], xv);
                if (mode == 0) {
#pragma unroll
                    for (int i = 0; i < 4; ++i) { S[i] = da[j][i] * S[i] + xv[i]; S[4 + i] = db[j][i] * S[4 + i] + xv[4 + i]; }
                } else {
                    const float mnew = fmaxf(be[j] + m, ml[j]); const float carry = __expf(be[j] + m - mnew), wl = __expf(ml[j] - mnew);
                    if (wr_m) X.MPREV[bhm * NCH + c] = m;
#pragma unroll
                    for (int i = 0; i < 8; ++i) S[i] = carry * S[i] + wl * xv[i];
                    m = mnew;
                }
            } }
#pragma unroll
        for (int j = 0; j < 4; ++j) { x[j] = y[j]; da[j] = ea[j]; db[j] = eb[j]; be[j] = be2[j]; ml[j] = ml2[j]; }
    }
}

__device__ __forceinline__ void la_phaseC(LAS unsigned char* lds, const LaCtx& X, int item) {
    int tid = threadIdx.x; asm volatile("" : "+v"(tid));
    const int wave = tid >> 6, lane = tid & 63, seg = tid >> 7, ch = tid & 127, fr = lane & 15, fq = lane >> 4;
    const int s = item / NCH, c = item - s * NCH, t0 = c * 64, mode = s >> 4;
    LAS bf16_t* QA = (LAS bf16_t*)(lds + L_QA); LAS bf16_t* KB = (LAS bf16_t*)(lds + L_KB); LAS bf16_t* QC = (LAS bf16_t*)(lds + L_QC);
    LAS bf16_t* VT = (LAS bf16_t*)(lds + L_VT); LAS bf16_t* ST = (LAS bf16_t*)(lds + L_ST); LAS bf16_t* PB = (LAS bf16_t*)(lds + L_PB);
    LAS float* SC = (LAS float*)(lds + L_SC);
    const bf16_t* dsb = X.DS + (size_t)item * ITEM_ELEMS;
#pragma unroll
    for (int j = 0; j < 4; ++j) { const int q = tid + 512 * j, row = q >> 4, cc = (q & 15) * 8; *(LAS u32x4*)(ST + row * LDQ + cc) = *(const u32x4*)(dsb + row * 128 + cc); }
    size_t rowbase; int colbase, hden = 0; bool wden = false;
    bf16_t vr[16];
    const int tg = tid >> 4, chb = (tid & 15) * 8;
    if (mode == 0) {
        const int b = s >> 3, h = s & 7; rowbase = (size_t)b * T; colbase = h * 128;
        float lfv[2][8]; u32x4 qraw[2], kraw[2];
#pragma unroll
        for (int j = 0; j < 2; ++j) { const int tt = t0 + 2 * tg + j; const bool ok = tt < T; const size_t row = rowbase + (ok ? tt : 0);
            const f32x4 a0 = *(const f32x4*)(X.AF + row * 1024 + h * 128 + chb), a1 = *(const f32x4*)(X.AF + row * 1024 + h * 128 + chb + 4);
            const u32x4 qq = *(const u32x4*)(X.PROJ + row * NP + C_AQ + h * 128 + chb), kk = *(const u32x4*)(X.PROJ + row * NP + C_AF + h * 128 + chb);
#pragma unroll
            for (int i = 0; i < 4; ++i) { lfv[j][i] = ok ? a0[i] : 0.f; lfv[j][4 + i] = ok ? a1[i] : 0.f; }
            qraw[j] = ok ? qq : (u32x4){0u, 0u, 0u, 0u}; kraw[j] = ok ? kk : (u32x4){0u, 0u, 0u, 0u}; }
#pragma unroll
        for (int i = 0; i < 16; ++i) { const int tt = t0 + seg * 16 + i; const bool ok = tt < T; const size_t row = rowbase + (ok ? tt : 0);
            vr[i] = ok ? X.PROJ[row * NP + C_AI + h * 128 + ch] : (bf16_t)0; }
        float incl[8], gsum[8];
#pragma unroll
        for (int i = 0; i < 8; ++i) { gsum[i] = lfv[0][i] + lfv[1][i]; float x = gsum[i];
            float y = __shfl_up(x, 16); if (lane >= 16) x += y;
            y = __shfl_up(x, 32); if (lane >= 32) x += y;
            incl[i] = x; }
        if (lane >= 48) {
#pragma unroll
            for (int i = 0; i < 8; ++i) SC[wave * 128 + chb + i] = incl[i];
        }
        LDS_BAR();
        float cg0[8], cg1[8], refv[8];
#pragma unroll
        for (int i = 0; i < 8; ++i) { float off = 0.f, ref = 0.f;
#pragma unroll
            for (int w = 0; w < 8; ++w) { const float x = SC[w * 128 + chb + i]; if (w < wave) off += x; if (w < 4) ref += x; }
            const float base = off + (incl[i] - gsum[i]);
            cg0[i] = base + lfv[0][i]; cg1[i] = base + gsum[i]; refv[i] = ref; }
#pragma unroll
        for (int j = 0; j < 2; ++j) { const int t = 2 * tg + j; float qf[8], kf[8], e1[8], e2[8], e3[8];
            unpack8(qraw[j], qf); unpack8(kraw[j], kf);
#pragma unroll
            for (int i = 0; i < 8; ++i) { const float cg = j ? cg1[i] : cg0[i]; e1[i] = qf[i] * __expf(cg - refv[i]); e2[i] = kf[i] * __expf(refv[i] - cg); e3[i] = qf[i] * __expf(cg); }
            *(LAS u32x4*)(QA + t * LDQ + chb) = pack8(e1); *(LAS u32x4*)(KB + t * LDQ + chb) = pack8(e2); *(LAS u32x4*)(QC + t * LDQ + chb) = pack8(e3); }
    } else {
        const int bhm = (s - 16) >> 1, vhalf = (s - 16) & 1, b = bhm >> 2, h = bhm & 3; rowbase = (size_t)b * T; colbase = 1024 + h * 256 + vhalf * 128; hden = h; wden = (vhalf == 0);
        u32x4 qraw[2];
#pragma unroll
        for (int j = 0; j < 2; ++j) { const int t = 2 * tg + j, tt = t0 + t; const bool ok = tt < T; const size_t row = rowbase + (ok ? tt : 0);
            const u32x4 qq = *(const u32x4*)(X.BQK + row * 1024 + h * 128 + chb), kk = *(const u32x4*)(X.BQK + row * 1024 + 512 + h * 128 + chb);
            qraw[j] = ok ? qq : (u32x4){0u, 0u, 0u, 0u};
            *(LAS u32x4*)(QA + t * LDQ + chb) = qraw[j]; *(LAS u32x4*)(KB + t * LDQ + chb) = ok ? kk : (u32x4){0u, 0u, 0u, 0u}; }
#pragma unroll
        for (int i = 0; i < 16; ++i) { const int tt = t0 + seg * 16 + i; const bool ok = tt < T; const size_t row = rowbase + (ok ? tt : 0);
            vr[i] = ok ? X.PROJ[row * NP + C_BV + h * 256 + vhalf * 128 + ch] : (bf16_t)0; }
        if (wave == 0) {
            const int tt = t0 + lane; const bool ok = tt < T; const size_t row = rowbase + (ok ? tt : 0);
            const float lfv = ok ? X.IL[row * 8 + 4 + h] : 0.f, igv = ok ? X.IL[row * 8 + h] : -1e30f;
            float bcs = lfv;
#pragma unroll
            for (int o = 1; o < 64; o <<= 1) { const float x = __shfl_up(bcs, o); if (lane >= o) bcs += x; }
            const float g = ok ? igv - bcs : -1e30f;
            float gp = g;
#pragma unroll
            for (int o = 1; o < 64; o <<= 1) { const float x = __shfl_up(gp, o); if (lane >= o) gp = fmaxf(gp, x); }
            const float mprev = X.MPREV[bhm * NCH + c];
            const float mt = fmaxf(bcs + mprev, bcs + gp);
            SC[1088 + lane] = g; SC[1152 + lane] = bcs - mt; SC[1216 + lane] = __expf(bcs + mprev - mt); SC[1280 + lane] = mt;
        }
        if (tid < 128) SC[1344 + tid] = bf1(dsb[128 * 128 + tid]);
        LDS_BAR();
#pragma unroll
        for (int j = 0; j < 2; ++j) { const int t = 2 * tg + j; float qf[8]; unpack8(qraw[j], qf); const float it = SC[1216 + t];
#pragma unroll
            for (int i = 0; i < 8; ++i) qf[i] *= it;
            *(LAS u32x4*)(QC + t * LDQ + chb) = pack8(qf); }
    }
    {
        u32x4 v0, v1;
        v0.x = vr[0] | ((unsigned)vr[1] << 16); v0.y = vr[2] | ((unsigned)vr[3] << 16); v0.z = vr[4] | ((unsigned)vr[5] << 16); v0.w = vr[6] | ((unsigned)vr[7] << 16);
        v1.x = vr[8] | ((unsigned)vr[9] << 16); v1.y = vr[10] | ((unsigned)vr[11] << 16); v1.z = vr[12] | ((unsigned)vr[13] << 16); v1.w = vr[14] | ((unsigned)vr[15] << 16);
        *(LAS u32x4*)(VT + ch * LDT + seg * 16) = v0; *(LAS u32x4*)(VT + ch * LDT + seg * 16 + 8) = v1;
    }
    LDS_BAR();
    const int t0b = (wave >> 1) * 16;
    {
        bf16x8 bq[4];
#pragma unroll
        for (int k = 0; k < 4; ++k) bq[k] = *(const LAS bf16x8*)(QA + (t0b + fr) * LDQ + k * 32 + fq * 8);
#pragma unroll
        for (int sbi = 0; sbi < 2; ++sbi) { const int s0 = ((wave & 1) * 2 + sbi) * 16;
            u32x2 o = (u32x2){0u, 0u};
            if (s0 <= t0b + 15) {
                f32x4 acc = (f32x4){0.f, 0.f, 0.f, 0.f};
#pragma unroll
                for (int k = 0; k < 4; ++k) { const bf16x8 a = *(const LAS bf16x8*)(KB + (s0 + fr) * LDQ + k * 32 + fq * 8); acc = __builtin_amdgcn_mfma_f32_16x16x32_bf16(a, bq[k], acc, 0, 0, 0); }
                const int t = t0b + fr; float p[4];
                float rt = 0.f; f32x4 ct = (f32x4){0.f, 0.f, 0.f, 0.f};
                if (mode == 1) { rt = SC[1152 + t]; ct = *(const LAS f32x4*)(SC + 1088 + s0 + fq * 4); }
#pragma unroll
                for (int j = 0; j < 4; ++j) { const int sidx = s0 + fq * 4 + j; float v = acc[j]; if (mode == 1) v *= __expf(rt + ct[j]); p[j] = (sidx <= t) ? v : 0.f; }
                o.x = cvt_pk_bf16(p[0], p[1]); o.y = cvt_pk_bf16(p[2], p[3]);
            }
            *(LAS u32x2*)(PB + (t0b + fr) * LDT + s0 + fq * 4) = o; }
    }
    LDS_BAR();
    {
        bf16x8 bp[2], bc[4];
#pragma unroll
        for (int k = 0; k < 2; ++k) bp[k] = *(const LAS bf16x8*)(PB + (t0b + fr) * LDT + k * 32 + fq * 8);
#pragma unroll
        for (int k = 0; k < 4; ++k) bc[k] = *(const LAS bf16x8*)(QC + (t0b + fr) * LDQ + k * 32 + fq * 8);
        const int tt = t0 + t0b + fr;
#pragma unroll
        for (int vbi = 0; vbi < 4; ++vbi) { const int v0 = ((wave & 1) * 4 + vbi) * 16; f32x4 acc = (f32x4){0.f, 0.f, 0.f, 0.f};
#pragma unroll
            for (int k = 0; k < 2; ++k) { const bf16x8 a = *(const LAS bf16x8*)(VT + (v0 + fr) * LDT + k * 32 + fq * 8); acc = __builtin_amdgcn_mfma_f32_16x16x32_bf16(a, bp[k], acc, 0, 0, 0); }
#pragma unroll
            for (int k = 0; k < 4; ++k) { const bf16x8 a = *(const LAS bf16x8*)(ST + (v0 + fr) * LDQ + k * 32 + fq * 8); acc = __builtin_amdgcn_mfma_f32_16x16x32_bf16(a, bc[k], acc, 0, 0, 0); }
            if (tt < T) { u32x2 o; o.x = cvt_pk_bf16(acc[0], acc[1]); o.y = cvt_pk_bf16(acc[2], acc[3]); *(u32x2*)(X.ORAW + (rowbase + tt) * 3072 + colbase + v0 + fq * 4) = o; } }
    }
    if (mode == 1 && wden && tid < 64) {
        const int t = tid; float sum = 0.f, qn = 0.f;
#pragma unroll
        for (int k = 0; k < 8; ++k) { float f8[8]; unpack8(*(const LAS u32x4*)(PB + t * LDT + k * 8), f8);
#pragma unroll
            for (int i = 0; i < 8; ++i) sum += f8[i]; }
#pragma unroll
        for (int k = 0; k < 16; ++k) { float f8[8]; unpack8(*(const LAS u32x4*)(QC + t * LDQ + k * 8), f8);
#pragma unroll
            for (int i = 0; i < 8; ++i) qn += f8[i] * SC[1344 + k * 8 + i]; }
        const int tt = t0 + t;
        if (tt < T) { X.DEN[(rowbase + tt) * 4 + hden] = sum + qn; X.MST[(rowbase + tt) * 4 + hden] = SC[1280 + t]; }
    }
    LDS_BAR();
}

constexpr int RW_ITEMS = 32 * NCH;
constexpr size_t RWI_P = 0, RWI_R = 8192, RWI_DEC = 16384, RWI_W = 16640, RWI_U = 24832, RWI_BYTES = 33024;
struct RwCtx { const bf16_t* CRKV; const bf16_t* CW; const bf16_t* CA; const float* kkp; const float* kap; unsigned char* RWI; bf16_t* SRW; bf16_t* ORAW; };
constexpr int RW_SCR = 114944;

struct RwTok { float r[8], kp[8], av[8], bv[8], v[8], cw[8], lw[8]; };
__device__ __forceinline__ void rw_prep(LAS float* SCR, const RwCtx& X, int b, int h, int t0, int tid, RwTok& K) {
    const int t = tid >> 3, dq = tid & 7, lane = tid & 63, wave = tid >> 6;
    const int tt = t0 + t; const bool ok = tt < T; const size_t row = (size_t)b * T + (ok ? tt : 0);
    const bf16_t* pr = X.CRKV + row * 3072 + h * 64 + dq * 8;
    float kr[8], aa[8];
    unpack8(*(const u32x4*)pr, K.r); unpack8(*(const u32x4*)(pr + 1024), kr); unpack8(*(const u32x4*)(pr + 2048), K.v);
    unpack8(*(const u32x4*)(X.CA + row * 1024 + h * 64 + dq * 8), aa); unpack8(*(const u32x4*)(X.CW + row * 1024 + h * 64 + dq * 8), K.lw);
    const f32x4 p0 = *(const f32x4*)(X.kkp + h * 64 + dq * 8), p1 = *(const f32x4*)(X.kkp + h * 64 + dq * 8 + 4);
    const f32x4 q0 = *(const f32x4*)(X.kap + h * 64 + dq * 8), q1 = *(const f32x4*)(X.kap + h * 64 + dq * 8 + 4);
    float kk[8]; float ss = 0.f;
#pragma unroll
    for (int i = 0; i < 8; ++i) { kk[i] = kr[i] * (i < 4 ? p0[i & 3] : p1[i & 3]); ss += kk[i] * kk[i]; }
    ss += __shfl_xor(ss, 1); ss += __shfl_xor(ss, 2); ss += __shfl_xor(ss, 4);
    const float inv = 1.0f / fmaxf(sqrtf(ss), 1e-12f);
#pragma unroll
    for (int i = 0; i < 8; ++i) { const float kn = kk[i] * inv, ka = (i < 4 ? q0[i & 3] : q1[i & 3]);
        K.av[i] = -kn; K.bv[i] = kn * aa[i]; K.kp[i] = kr[i] * (1.0f + (aa[i] - 1.0f) * ka);
        if (!ok) { K.av[i] = 0.f; K.bv[i] = 0.f; K.kp[i] = 0.f; K.r[i] = 0.f; K.v[i] = 0.f; K.lw[i] = 0.f; } }
#pragma unroll
    for (int i = 0; i < 8; ++i) { float x = K.lw[i];
#pragma unroll
        for (int o = 8; o < 64; o <<= 1) { const float y = __shfl_up(x, o); if (lane >= o) x += y; }
        K.cw[i] = x; }
    if ((lane >> 3) == 7) {
#pragma unroll
        for (int i = 0; i < 8; ++i) SCR[wave * 64 + dq * 8 + i] = K.cw[i];
    }
    LDS_BAR();
#pragma unroll
    for (int i = 0; i < 8; ++i) { float off = 0.f;
#pragma unroll
        for (int w = 0; w < 7; ++w) if (w < wave) off += SCR[w * 64 + dq * 8 + i];
        K.cw[i] += off; }
}
__device__ __forceinline__ void rw_refs(const LAS float* SCR, int dq, float (&ref)[8], float (&cend)[8]) {
#pragma unroll
    for (int i = 0; i < 8; ++i) { float a = 0.f, b = 0.f;
#pragma unroll
        for (int w = 0; w < 8; ++w) { const float x = SCR[w * 64 + dq * 8 + i]; if (w < 4) a += x; b += x; }
        ref[i] = a; cend[i] = a + (b - a); cend[i] = b; }
}
__device__ __forceinline__ u32x4 pack8v(const float (&f)[8]) { return pack8(f); }

__device__ __forceinline__ void rw_phaseA(LAS unsigned char* lds, const RwCtx& X, int item) {
    int tid = threadIdx.x; asm volatile("" : "+v"(tid));
    const int wave = tid >> 6, lane = tid & 63, fr = lane & 15, fq = lane >> 4, t = tid >> 3, dq = tid & 7;
    const int bh = item / NCH, c = item - bh * NCH, b = bh >> 4, h = bh & 15, t0 = c * 64;
    LAS bf16_t* AT = (LAS bf16_t*)(lds + 0); LAS bf16_t* BB = (LAS bf16_t*)(lds + 9216); LAS bf16_t* KB = (LAS bf16_t*)(lds + 18432);
    LAS bf16_t* BtT = (LAS bf16_t*)(lds + 27648); LAS bf16_t* KtT = (LAS bf16_t*)(lds + 36864); LAS bf16_t* VT = (LAS bf16_t*)(lds + 46080);
    LAS float* XS = (LAS float*)(lds + 55296);
    LAS float* LAB = (LAS float*)(lds + 88320);
    LAS bf16_t* LAK = (LAS bf16_t*)(lds + 105728);
    LAS float* SCR = (LAS float*)(lds + RW_SCR);
    LAS bf16_t* Wt = (LAS bf16_t*)(lds + 0); LAS bf16_t* Ut = (LAS bf16_t*)(lds + 8192);
    LAS bf16_t* WT = (LAS bf16_t*)(lds + 18432); LAS bf16_t* UT = (LAS bf16_t*)(lds + 105728);
    unsigned char* gi = X.RWI + (size_t)item * RWI_BYTES;
    {
        RwTok K; rw_prep(SCR, X, b, h, t0, tid, K);
        float e1[8], e2[8], e3[8], e4[8];
        float refv[8], cendv[8]; rw_refs(SCR, dq, refv, cendv);
#pragma unroll
        for (int i = 0; i < 8; ++i) { const float ref = refv[i], cend = cendv[i];
            const float as = K.av[i] * __expf(K.cw[i] - K.lw[i]);
            XS[t * 129 + dq * 8 + i] = as;
            e1[i] = K.av[i] * __expf(K.cw[i] - K.lw[i] - ref); const float eb = __expf(ref - K.cw[i]); e2[i] = K.bv[i] * eb; e3[i] = K.kp[i] * eb;
            const float et = __expf(cend - K.cw[i]); e4[i] = et;
            BtT[(dq * 8 + i) * 72 + t] = f2bf(K.bv[i] * et); KtT[(dq * 8 + i) * 72 + t] = f2bf(K.kp[i] * et); VT[(dq * 8 + i) * 72 + t] = f2bf(K.v[i]);
            if (t == 0) *(float*)(gi + RWI_DEC + (dq * 8 + i) * 4) = __expf(cend); }
        *(LAS u32x4*)(AT + t * 72 + dq * 8) = pack8(e1); *(LAS u32x4*)(BB + t * 72 + dq * 8) = pack8(e2); *(LAS u32x4*)(KB + t * 72 + dq * 8) = pack8(e3);
        (void)e4;
    }
    LDS_BAR();
    const int t0b = (wave >> 1) * 16;
    {
        bf16x8 fa[2];
#pragma unroll
        for (int k = 0; k < 2; ++k) fa[k] = *(const LAS bf16x8*)(AT + (t0b + fr) * 72 + k * 32 + fq * 8);
#pragma unroll
        for (int sbi = 0; sbi < 2; ++sbi) { const int s0 = ((wave & 1) * 2 + sbi) * 16;
            f32x4 acc = (f32x4){0.f, 0.f, 0.f, 0.f}, acc2 = acc;
            if (s0 <= t0b + 15) {
#pragma unroll
                for (int k = 0; k < 2; ++k) { const bf16x8 fb = *(const LAS bf16x8*)(BB + (s0 + fr) * 72 + k * 32 + fq * 8), fk = *(const LAS bf16x8*)(KB + (s0 + fr) * 72 + k * 32 + fq * 8);
                    acc = __builtin_amdgcn_mfma_f32_16x16x32_bf16(fa[k], fb, acc, 0, 0, 0);
                    acc2 = __builtin_amdgcn_mfma_f32_16x16x32_bf16(fk, fa[k], acc2, 0, 0, 0); }
            }
#pragma unroll
            for (int j = 0; j < 4; ++j) { const int tt = t0b + fq * 4 + j, sidx = s0 + fr; LAB[tt * 68 + sidx] = (sidx < tt) ? acc[j] : 0.f; }
            float p[4];
#pragma unroll
            for (int j = 0; j < 4; ++j) p[j] = (s0 + fq * 4 + j < t0b + fr) ? acc2[j] : 0.f;
            u32x2 o; o.x = cvt_pk_bf16(p[0], p[1]); o.y = cvt_pk_bf16(p[2], p[3]);
            *(LAS u32x2*)(LAK + (t0b + fr) * 72 + s0 + fq * 4) = o; }
    }
    LDS_BAR();
    {
        bf16x8 fl[2];
#pragma unroll
        for (int k = 0; k < 2; ++k) fl[k] = *(const LAS bf16x8*)(LAK + (t0b + fr) * 72 + k * 32 + fq * 8);
#pragma unroll
        for (int bi = 0; bi < 2; ++bi) { const int v0 = ((wave & 1) * 2 + bi) * 16; f32x4 acc = (f32x4){0.f, 0.f, 0.f, 0.f};
#pragma unroll
            for (int k = 0; k < 2; ++k) { const bf16x8 fv = *(const LAS bf16x8*)(VT + (v0 + fr) * 72 + k * 32 + fq * 8); acc = __builtin_amdgcn_mfma_f32_16x16x32_bf16(fl[k], fv, acc, 0, 0, 0); }
#pragma unroll
            for (int j = 0; j < 4; ++j) XS[(t0b + fq * 4 + j) * 129 + 64 + v0 + fr] = acc[j]; }
    }
    LDS_BAR();
    int tid_s = threadIdx.x; asm volatile("" : "+v"(tid_s));
    if (tid_s < 128) {
        float x[64];
        int zv = 0; asm volatile("" : "+v"(zv));
        const LAS float* LABv = LAB + zv;
#pragma unroll
        for (int i = 0; i < 64; ++i) x[i] = XS[i * 129 + tid_s];
#pragma unroll
        for (int tt = 1; tt < 64; ++tt) { float a = x[tt];
#pragma unroll
            for (int s4 = 0; s4 < (tt + 3) / 4; ++s4) { const f32x4 l4 = *(const LAS f32x4*)(LABv + tt * 68 + s4 * 4);
                a += l4[0] * x[s4 * 4]; if (s4 * 4 + 1 < tt) a += l4[1] * x[s4 * 4 + 1]; if (s4 * 4 + 2 < tt) a += l4[2] * x[s4 * 4 + 2]; if (s4 * 4 + 3 < tt) a += l4[3] * x[s4 * 4 + 3]; }
            x[tt] = a;
#ifdef SOLVER_SB
            __builtin_amdgcn_sched_barrier(0);
#endif
        }
        LAS bf16_t* rowT = (tid_s < 64) ? (WT + tid_s * 72) : (UT + (tid_s - 64) * 72);
        LAS bf16_t* colN = (tid_s < 64) ? (Wt + tid_s) : (Ut + (tid_s - 64));
#pragma unroll
        for (int g = 0; g < 8; ++g) { u32x4 o; o.x = cvt_pk_bf16(x[8 * g], x[8 * g + 1]); o.y = cvt_pk_bf16(x[8 * g + 2], x[8 * g + 3]); o.z = cvt_pk_bf16(x[8 * g + 4], x[8 * g + 5]); o.w = cvt_pk_bf16(x[8 * g + 6], x[8 * g + 7]);
            *(LAS u32x4*)(rowT + 8 * g) = o; }
#pragma unroll
        for (int i = 0; i < 64; ++i) colN[i * 64] = f2bf(x[i]);
    }
    LDS_BAR();
    {
        int tid = threadIdx.x; asm volatile("" : "+v"(tid));
        const int wave = tid >> 6, lane = tid & 63, fr = lane & 15, fq = lane >> 4;
        const int d0 = (wave >> 1) * 16;
        bf16x8 fb[2], fk2[2];
#pragma unroll
        for (int k = 0; k < 2; ++k) { fb[k] = *(const LAS bf16x8*)(BtT + (d0 + fr) * 72 + k * 32 + fq * 8); fk2[k] = *(const LAS bf16x8*)(KtT + (d0 + fr) * 72 + k * 32 + fq * 8); }
#pragma unroll
        for (int bi = 0; bi < 2; ++bi) { const int n0 = ((wave & 1) * 2 + bi) * 16; f32x4 accp = (f32x4){0.f, 0.f, 0.f, 0.f}; f32x4 accr = accp;
#pragma unroll
            for (int k = 0; k < 2; ++k) { const bf16x8 fw = *(const LAS bf16x8*)(WT + (n0 + fr) * 72 + k * 32 + fq * 8), fu = *(const LAS bf16x8*)(UT + (n0 + fr) * 72 + k * 32 + fq * 8), fv = *(const LAS bf16x8*)(VT + (n0 + fr) * 72 + k * 32 + fq * 8);
                accp = __builtin_amdgcn_mfma_f32_16x16x32_bf16(fw, fb[k], accp, 0, 0, 0);
                accr = __builtin_amdgcn_mfma_f32_16x16x32_bf16(fb[k], fu, accr, 0, 0, 0);
                accr = __builtin_amdgcn_mfma_f32_16x16x32_bf16(fk2[k], fv, accr, 0, 0, 0); }
            u32x2 op; op.x = cvt_pk_bf16(accp[0], accp[1]); op.y = cvt_pk_bf16(accp[2], accp[3]);
            *(u32x2*)(gi + RWI_P + ((size_t)(d0 + fr) * 64 + n0 + fq * 4) * 2) = op;
            u32x2 orr; orr.x = cvt_pk_bf16(accr[0], accr[1]); orr.y = cvt_pk_bf16(accr[2], accr[3]);
            *(u32x2*)(gi + RWI_R + ((size_t)((wave * 2 + bi) * 64 + lane)) * 8) = orr; }
#pragma unroll
        for (int j = 0; j < 2; ++j) { const int q = tid + 512 * j; *(u32x4*)(gi + RWI_W + (size_t)q * 16) = *(const LAS u32x4*)(lds + (size_t)q * 16); }
    }
    LDS_BAR();
}

__device__ __forceinline__ void rw_phaseB(LAS unsigned char* lds, const RwCtx& X, int bh) {
    int tid = threadIdx.x; asm volatile("" : "+v"(tid));
    const int wave = tid >> 6, lane = tid & 63, fr = lane & 15, fq = lane >> 4;
    const int d0 = (wave >> 1) * 16, vb0 = (wave & 1) * 2;
    f32x4 acc[2]; acc[0] = (f32x4){0.f, 0.f, 0.f, 0.f}; acc[1] = acc[0];
    const unsigned char* gi = X.RWI + (size_t)bh * NCH * RWI_BYTES;
    bf16x8 pa[4][2], pn[4][2]; u32x2 rf[4][2], rn[4][2]; f32x4 dc[4], dn[4];
#define RWB_LOAD(PA, RF, DC, cc) do { const unsigned char* g_ = gi + (size_t)(cc) * RWI_BYTES; \
        _Pragma("unroll") for (int k = 0; k < 2; ++k) PA[k] = *(const bf16x8*)(g_ + RWI_P + ((size_t)(d0 + fr) * 64 + k * 32 + fq * 8) * 2); \
        _Pragma("unroll") for (int bi = 0; bi < 2; ++bi) RF[bi] = *(const u32x2*)(g_ + RWI_R + ((size_t)((wave * 2 + bi) * 64 + lane)) * 8); \
        DC = *(const f32x4*)(g_ + RWI_DEC + (d0 + fq * 4) * 4); } while (0)
#pragma unroll
    for (int j = 0; j < 4; ++j) RWB_LOAD(pa[j], rf[j], dc[j], j);
    for (int c0 = 0; c0 < NCH; c0 += 4) {
#pragma unroll
        for (int j = 0; j < 4; ++j) { const int cn = c0 + 4 + j;
            if (cn < NCH) RWB_LOAD(pn[j], rn[j], dn[j], cn);
            else { pn[j][0] = pa[j][0]; pn[j][1] = pa[j][1]; rn[j][0] = rf[j][0]; rn[j][1] = rf[j][1]; dn[j] = dc[j]; } }
#pragma unroll
        for (int j = 0; j < 4; ++j) { const int c = c0 + j;
            if (c < NCH) {
                LAS bf16_t* STb = (LAS bf16_t*)(lds + (c & 1) * 9216);
                bf16_t* sg = X.SRW + ((size_t)bh * NCH + c) * 4096;
#pragma unroll
                for (int bi = 0; bi < 2; ++bi) { const int v0 = (vb0 + bi) * 16; u32x2 o; o.x = cvt_pk_bf16(acc[bi][0], acc[bi][1]); o.y = cvt_pk_bf16(acc[bi][2], acc[bi][3]);
                    *(LAS u32x2*)(STb + (v0 + fr) * 72 + d0 + fq * 4) = o; *(u32x2*)(sg + (v0 + fr) * 64 + d0 + fq * 4) = o; }
                LDS_BAR();
#pragma unroll
                for (int bi = 0; bi < 2; ++bi) { const int v0 = (vb0 + bi) * 16;
                    f32x4 n = (f32x4){dc[j][0] * acc[bi][0] + bflo(rf[j][bi].x), dc[j][1] * acc[bi][1] + bfhi(rf[j][bi].x), dc[j][2] * acc[bi][2] + bflo(rf[j][bi].y), dc[j][3] * acc[bi][3] + bfhi(rf[j][bi].y)};
#pragma unroll
                    for (int k = 0; k < 2; ++k) { const bf16x8 fs = *(const LAS bf16x8*)(STb + (v0 + fr) * 72 + k * 32 + fq * 8); n = __builtin_amdgcn_mfma_f32_16x16x32_bf16(pa[j][k], fs, n, 0, 0, 0); }
                    acc[bi] = n; }
            } }
#pragma unroll
        for (int j = 0; j < 4; ++j) { pa[j][0] = pn[j][0]; pa[j][1] = pn[j][1]; rf[j][0] = rn[j][0]; rf[j][1] = rn[j][1]; dc[j] = dn[j]; }
    }
#undef RWB_LOAD
    LDS_BAR();
}

__device__ __forceinline__ void rw_phaseC(LAS unsigned char* lds, const RwCtx& X, int item) {
    int tid = threadIdx.x; asm volatile("" : "+v"(tid));
    const int wave = tid >> 6, lane = tid & 63, fr = lane & 15, fq = lane >> 4, t = tid >> 3, dq = tid & 7;
    const int bh = item / NCH, c = item - bh * NCH, b = bh >> 4, h = bh & 15, t0 = c * 64;
    LAS bf16_t* RT = (LAS bf16_t*)(lds + 0); LAS bf16_t* BB = (LAS bf16_t*)(lds + 9216); LAS bf16_t* KB = (LAS bf16_t*)(lds + 18432);
    LAS bf16_t* RS = (LAS bf16_t*)(lds + 27648); LAS bf16_t* VT = (LAS bf16_t*)(lds + 36864); LAS bf16_t* ST = (LAS bf16_t*)(lds + 46080);
    LAS bf16_t* Wt = (LAS bf16_t*)(lds + 55296); LAS bf16_t* RB = (LAS bf16_t*)(lds + 64512); LAS bf16_t* RK = (LAS bf16_t*)(lds + 73728); LAS bf16_t* UT = (LAS bf16_t*)(lds + 82944);
    LAS float* SCR = (LAS float*)(lds + RW_SCR);
    const unsigned char* gi = X.RWI + (size_t)item * RWI_BYTES;
    const int t0b = (wave >> 1) * 16;
    float u0v[2][4];
    { const bf16_t* u0g = (const bf16_t*)(gi + RWI_U);
#pragma unroll
      for (int bi = 0; bi < 2; ++bi)
#pragma unroll
        for (int j = 0; j < 4; ++j) u0v[bi][j] = bf1(u0g[(t0b + fq * 4 + j) * 64 + ((wave & 1) * 2 + bi) * 16 + fr]); }
    {
        *(LAS u32x4*)(ST + t * 72 + dq * 8) = *(const u32x4*)(X.SRW + (size_t)item * 4096 + t * 64 + dq * 8);
        *(LAS u32x4*)(Wt + t * 72 + dq * 8) = *(const u32x4*)(gi + RWI_W + ((size_t)t * 64 + dq * 8) * 2);
    }
    {
        RwTok K; rw_prep(SCR, X, b, h, t0, tid, K);
        float e1[8], e2[8], e3[8], e4[8];
        float refv[8], cendv[8]; rw_refs(SCR, dq, refv, cendv); (void)cendv;
#pragma unroll
        for (int i = 0; i < 8; ++i) { const float ref = refv[i];
            e1[i] = K.r[i] * __expf(K.cw[i] - ref); const float eb = __expf(ref - K.cw[i]); e2[i] = K.bv[i] * eb; e3[i] = K.kp[i] * eb; e4[i] = K.r[i] * __expf(K.cw[i]);
            VT[(dq * 8 + i) * 72 + t] = f2bf(K.v[i]); }
        *(LAS u32x4*)(RT + t * 72 + dq * 8) = pack8(e1); *(LAS u32x4*)(BB + t * 72 + dq * 8) = pack8(e2); *(LAS u32x4*)(KB + t * 72 + dq * 8) = pack8(e3); *(LAS u32x4*)(RS + t * 72 + dq * 8) = pack8(e4);
    }
    LDS_BAR();
    {
        bf16x8 fa[2];
#pragma unroll
        for (int k = 0; k < 2; ++k) fa[k] = *(const LAS bf16x8*)(RT + (t0b + fr) * 72 + k * 32 + fq * 8);
#pragma unroll
        for (int sbi = 0; sbi < 2; ++sbi) { const int s0 = ((wave & 1) * 2 + sbi) * 16;
            f32x4 ab = (f32x4){0.f, 0.f, 0.f, 0.f}, ak = ab;
            if (s0 <= t0b + 15) {
#pragma unroll
                for (int k = 0; k < 2; ++k) { const bf16x8 fb = *(const LAS bf16x8*)(BB + (s0 + fr) * 72 + k * 32 + fq * 8), fk = *(const LAS bf16x8*)(KB + (s0 + fr) * 72 + k * 32 + fq * 8);
                    ab = __builtin_amdgcn_mfma_f32_16x16x32_bf16(fb, fa[k], ab, 0, 0, 0);
                    ak = __builtin_amdgcn_mfma_f32_16x16x32_bf16(fk, fa[k], ak, 0, 0, 0); }
            }
            float pb[4], pk[4];
#pragma unroll
            for (int j = 0; j < 4; ++j) { const bool m = (s0 + fq * 4 + j <= t0b + fr); pb[j] = m ? ab[j] : 0.f; pk[j] = m ? ak[j] : 0.f; }
            u32x2 o1, o2; o1.x = cvt_pk_bf16(pb[0], pb[1]); o1.y = cvt_pk_bf16(pb[2], pb[3]); o2.x = cvt_pk_bf16(pk[0], pk[1]); o2.y = cvt_pk_bf16(pk[2], pk[3]);
            *(LAS u32x2*)(RB + (t0b + fr) * 72 + s0 + fq * 4) = o1; *(LAS u32x2*)(RK + (t0b + fr) * 72 + s0 + fq * 4) = o2; }
        bf16x8 fw[2];
#pragma unroll
        for (int k = 0; k < 2; ++k) fw[k] = *(const LAS bf16x8*)(Wt + (t0b + fr) * 72 + k * 32 + fq * 8);
#pragma unroll
        for (int bi = 0; bi < 2; ++bi) { const int v0 = ((wave & 1) * 2 + bi) * 16; f32x4 acc;
#pragma unroll
            for (int j = 0; j < 4; ++j) acc[j] = u0v[bi][j];
#pragma unroll
            for (int k = 0; k < 2; ++k) { const bf16x8 fs = *(const LAS bf16x8*)(ST + (v0 + fr) * 72 + k * 32 + fq * 8); acc = __builtin_amdgcn_mfma_f32_16x16x32_bf16(fw[k], fs, acc, 0, 0, 0); }
            u32x2 o; o.x = cvt_pk_bf16(acc[0], acc[1]); o.y = cvt_pk_bf16(acc[2], acc[3]);
            *(LAS u32x2*)(UT + (v0 + fr) * 72 + t0b + fq * 4) = o; }
    }
    LDS_BAR();
    {
        bf16x8 f1[2], f2[2], f3[2];
#pragma unroll
        for (int k = 0; k < 2; ++k) { f1[k] = *(const LAS bf16x8*)(RS + (t0b + fr) * 72 + k * 32 + fq * 8); f2[k] = *(const LAS bf16x8*)(RB + (t0b + fr) * 72 + k * 32 + fq * 8); f3[k] = *(const LAS bf16x8*)(RK + (t0b + fr) * 72 + k * 32 + fq * 8); }
        const int tt = t0 + t0b + fr;
#pragma unroll
        for (int bi = 0; bi < 2; ++bi) { const int v0 = ((wave & 1) * 2 + bi) * 16; f32x4 acc = (f32x4){0.f, 0.f, 0.f, 0.f};
#pragma unroll
            for (int k = 0; k < 2; ++k) { const bf16x8 a1 = *(const LAS bf16x8*)(ST + (v0 + fr) * 72 + k * 32 + fq * 8), a2 = *(const LAS bf16x8*)(UT + (v0 + fr) * 72 + k * 32 + fq * 8), a3 = *(const LAS bf16x8*)(VT + (v0 + fr) * 72 + k * 32 + fq * 8);
                acc = __builtin_amdgcn_mfma_f32_16x16x32_bf16(a1, f1[k], acc, 0, 0, 0); acc = __builtin_amdgcn_mfma_f32_16x16x32_bf16(a2, f2[k], acc, 0, 0, 0); acc = __builtin_amdgcn_mfma_f32_16x16x32_bf16(a3, f3[k], acc, 0, 0, 0); }
            if (tt < T) { u32x2 o; o.x = cvt_pk_bf16(acc[0], acc[1]); o.y = cvt_pk_bf16(acc[2], acc[3]); *(u32x2*)(X.ORAW + ((size_t)b * T + tt) * 3072 + 2048 + h * 64 + v0 + fq * 4) = o; } }
    }
    LDS_BAR();
}

constexpr int MT = 16384;
template <int K>
__device__ __forceinline__ void skinny_partial(const bf16_t* A, const bf16_t* Bt, int c0, int wave, int fr, int fq, f32x4 (&acc)[2]) {
    constexpr int kw = K >> 3; const int k0 = wave * kw;
    acc[0] = (f32x4){0.f, 0.f, 0.f, 0.f}; acc[1] = acc[0];
#pragma unroll
    for (int k = 0; k < kw; k += 32) {
        const bf16x8 fb = *(const bf16x8*)(Bt + (size_t)(c0 + fr) * K + k0 + k + fq * 8);
        const bf16x8 a0 = *(const bf16x8*)(A + (size_t)fr * K + k0 + k + fq * 8), a1 = *(const bf16x8*)(A + (size_t)(16 + fr) * K + k0 + k + fq * 8);
        acc[0] = __builtin_amdgcn_mfma_f32_16x16x32_bf16(a0, fb, acc[0], 0, 0, 0);
        acc[1] = __builtin_amdgcn_mfma_f32_16x16x32_bf16(a1, fb, acc[1], 0, 0, 0);
    }
}
__device__ __forceinline__ f32x4 skinny_reduce(LAS float* red, const f32x4 (&acc)[2], int wave, int lane) {
    *(LAS f32x4*)(red + ((wave * 2 + 0) * 64 + lane) * 4) = acc[0]; *(LAS f32x4*)(red + ((wave * 2 + 1) * 64 + lane) * 4) = acc[1];
    __syncthreads();
    f32x4 s = (f32x4){0.f, 0.f, 0.f, 0.f};
    if (wave < 2) {
#pragma unroll
        for (int w = 0; w < 8; ++w) s += *(const LAS f32x4*)(red + ((w * 2 + wave) * 64 + lane) * 4);
    }
    __syncthreads();
    return s;
}
__device__ __forceinline__ void skinny_g2(LAS float* red, const bf16_t* Y, const bf16_t* WBRl, const bf16_t* PROJ, bf16_t* MERGED, int c0) {
    int tid = threadIdx.x; asm volatile("" : "+v"(tid));
    const int wave = tid >> 6, lane = tid & 63, fr = lane & 15, fq = lane >> 4;
    f32x4 tot = (f32x4){0.f, 0.f, 0.f, 0.f};
    for (int z = 0; z < 3; ++z) {
        f32x4 acc[2]; skinny_partial<1024>(Y + ((size_t)z * MP + MT) * 1024, WBRl + (size_t)z * D * 1024, c0, wave, fr, fq, acc);
        const f32x4 s = skinny_reduce(red, acc, wave, lane);
        if (wave < 2) {
#pragma unroll
            for (int j = 0; j < 4; ++j) { const int row = MT + wave * 16 + fq * 4 + j; tot[j] += s[j] * bf1(PROJ[(size_t)row * NP + C_G + z * 2048 + c0 + fr]); }
        }
    }
    if (wave < 2) {
#pragma unroll
        for (int j = 0; j < 4; ++j) { const int row = MT + wave * 16 + fq * 4 + j; MERGED[(size_t)row * D + c0 + fr] = f2bf(tot[j]); }
    }
}
__device__ __forceinline__ void skinny_g1b(LAS float* red, const bf16_t* ALR, const bf16_t* WLRl, const float* w0l, const float* a0l, bf16_t* CW, bf16_t* CA, int c0) {
    int tid = threadIdx.x; asm volatile("" : "+v"(tid));
    const int wave = tid >> 6, lane = tid & 63, fr = lane & 15, fq = lane >> 4;
    f32x4 acc[2]; skinny_partial<256>(ALR + (size_t)MT * 256, WLRl, c0, wave, fr, fq, acc);
    const f32x4 s = skinny_reduce(red, acc, wave, lane);
    if (wave < 2) {
        const int col = c0 + fr;
#pragma unroll
        for (int j = 0; j < 4; ++j) { const int row = MT + wave * 16 + fq * 4 + j;
            if (col < 1024) CW[(size_t)row * 1024 + col] = f2bf(-0.6065306597126334f * sigmoidf_(w0l[col] + s[j]));
            else CA[(size_t)row * 1024 + (col - 1024)] = f2bf(sigmoidf_(a0l[col - 1024] + s[j])); }
    }
}
__device__ __forceinline__ void skinny_g3(LAS float* red, const bf16_t* MERGED, const bf16_t* WOUTl, float* H, int c0) {
    int tid = threadIdx.x; asm volatile("" : "+v"(tid));
    const int wave = tid >> 6, lane = tid & 63, fr = lane & 15, fq = lane >> 4;
    f32x4 acc[2]; skinny_partial<D>(MERGED + (size_t)MT * D, WOUTl, c0, wave, fr, fq, acc);
    const f32x4 s = skinny_reduce(red, acc, wave, lane);
    if (wave < 2) {
#pragma unroll
        for (int j = 0; j < 4; ++j) { const int row = MT + wave * 16 + fq * 4 + j; H[(size_t)row * D + c0 + fr] += s[j]; }
    }
}

__global__ void __launch_bounds__(NTHREADS, 2) fwd_megakernel(Args args) {
    extern __shared__ __attribute__((aligned(16))) unsigned char lds_raw[];
    cg::grid_group grid = cg::this_grid();
    LAS unsigned char* lds = (LAS unsigned char*)lds_raw;
    LAS float* ldsf = (LAS float*)lds_raw;
    if (threadIdx.x == 0) { ((volatile LAS unsigned*)(lds + 131072))[0] = 0u; ((volatile LAS unsigned*)(lds + 131072))[1] = 0u; }
    __syncthreads();
    const XcdBarrier gbar = xcd_barrier_post((unsigned*)(args.ws + WS_BAR), (volatile LAS unsigned*)(lds + 131072));
    const int G = gridDim.x, NGW = G * NWAVES;
    const size_t GT = (size_t)G * NTHREADS;
#define PHASE_IDS int tid = threadIdx.x; asm volatile("" : "+v"(tid)); const int lane = tid & 63, wave = tid >> 6, gw = blockIdx.x * NWAVES + wave; const size_t gt = (size_t)blockIdx.x * NTHREADS + tid; (void)lane; (void)gw; (void)gt;
    unsigned char* ws = args.ws;
    const float* x = args.in[0]; const float* meta = args.in[1]; const float* norm_g = args.in[2]; const float* w_in = args.in[3];
    const float* lb_logits = args.in[4]; const float* hgrn_g = args.in[5]; const float* mconv = args.in[6]; const float* ig_b = args.in[7];
    const float* fg_b = args.in[8]; const float* mnorm_g = args.in[9]; const float* mu = args.in[10]; const float* w0 = args.in[11];
    const float* w_up = args.in[12]; const float* a0 = args.in[13]; const float* a_up = args.in[14]; const float* k_k = args.in[15];
    const float* k_a = args.in[16]; const float* r_k = args.in[17]; const float* ln_g = args.in[18]; const float* ln_b = args.in[19];
    const float* w_br = args.in[20]; const float* w_out = args.in[21]; const float* fin_g = args.in[22];
    bf16_t* WINT = (bf16_t*)(ws + WS_WINT); bf16_t* WBRT = (bf16_t*)(ws + WS_WBRT); bf16_t* WOUTT = (bf16_t*)(ws + WS_WOUTT); bf16_t* WLRT = (bf16_t*)(ws + WS_WLRT);
    float* LB = (float*)(ws + WS_LB); float* H = (float*)(ws + WS_H); bf16_t* XN = (bf16_t*)(ws + WS_XN); bf16_t* PROJ = (bf16_t*)(ws + WS_PROJ);
    float* AF = (float*)(ws + WS_AF); float* IGFG = (float*)(ws + WS_IGFG); bf16_t* BQK = (bf16_t*)(ws + WS_BQK); float* IL = (float*)(ws + WS_IL);
    bf16_t* CRKV = (bf16_t*)(ws + WS_CRKV); bf16_t* ALR = (bf16_t*)(ws + WS_ALR); bf16_t* CW = (bf16_t*)(ws + WS_CW); bf16_t* CA = (bf16_t*)(ws + WS_CA);
    bf16_t* ORAW = (bf16_t*)(ws + WS_ORAW); float* DEN = (float*)(ws + WS_DEN); float* MST = (float*)(ws + WS_MST); bf16_t* Y = (bf16_t*)(ws + WS_Y);
    float* MACC = (float*)(ws + WS_MACC); bf16_t* MERGED = (bf16_t*)(ws + WS_MERGED);

#ifndef NO_P0
    {
        PHASE_IDS
        constexpr int I_IN = 32 * 291, I_BR = 16 * 32, I_OUT = 32 * 32, I_LR = 16;
        constexpr int NITEMS = DEPTH * I_IN + DEPTH * 3 * I_BR + DEPTH * I_OUT + DEPTH * 2 * I_LR;
        for (int it = gw; it < NITEMS; it += NGW) {
            int r = it;
            if (r < DEPTH * I_IN) { const int l = r / I_IN; tr_item<true, false>(w_in + (size_t)l * D * NIN, NIN, WINT + (size_t)l * NP * D, D, 0, r % I_IN, lane); continue; }
            r -= DEPTH * I_IN;
            if (r < DEPTH * 3 * I_BR) { const int mi = r / I_BR; tr_item<false, false>(w_br + (size_t)mi * 1024 * D, D, WBRT + (size_t)mi * D * 1024, 1024, 0, r % I_BR, lane); continue; }
            r -= DEPTH * 3 * I_BR;
            if (r < DEPTH * I_OUT) { const int l = r / I_OUT; tr_item<false, false>(w_out + (size_t)l * D * D, D, WOUTT + (size_t)l * D * D, D, 0, r % I_OUT, lane); continue; }
            r -= DEPTH * I_OUT;
            { const int l = r / (2 * I_LR), q = r % (2 * I_LR);
              if (q < I_LR) tr_item<false, true>(w_up + (size_t)l * 64 * 1024, 1024, WLRT + (size_t)l * 2048 * 256, 256, 0, q, lane);
              else tr_item<false, true>(a_up + (size_t)l * 64 * 1024, 1024, WLRT + ((size_t)l * 2048 + 1024) * 256, 256, 64, q - I_LR, lane); }
        }
        for (size_t i = gt; i < (size_t)DEPTH * (NP - NIN) * D / 8; i += GT) { const size_t per = (size_t)(NP - NIN) * D / 8; const size_t l = i / per, o = i % per;
            *(u32x4*)(WINT + (l * NP + NIN) * D + o * 8) = (u32x4){0u, 0u, 0u, 0u}; }
        for (size_t i = gt; i < 1024; i += GT) { float e[4], mx = -1e30f, s = 0.f;
#pragma unroll
            for (int l = 0; l < 4; ++l) { e[l] = lb_logits[l * 1024 + i]; mx = fmaxf(mx, e[l]); }
#pragma unroll
            for (int l = 0; l < 4; ++l) { e[l] = expf(e[l] - mx); s += e[l]; }
            const float p1 = e[1] / s, p2 = e[2] / s, p3 = e[3] / s;
            LB[i] = 0.f; LB[1024 + i] = p1; LB[2048 + i] = p1 + p2; LB[3072 + i] = p1 + p2 + p3; }
#pragma unroll 2
        for (int r = gw; r < M; r += NGW) { const int b = r / T, t = r - b * T;
            const float* src = (t < NMETA) ? meta + (size_t)t * D : x + ((size_t)b * SEQ + (t - NMETA)) * D;
            rms_row(src, H + (size_t)r * D, norm_g, XN + (size_t)r * D, lane); }
        for (size_t i = gt; i < (size_t)(MP - M) * D / 8; i += GT) { *(u32x4*)(XN + (size_t)M * D + i * 8) = (u32x4){0u, 0u, 0u, 0u}; *(u32x4*)(MERGED + (size_t)M * D + i * 8) = (u32x4){0u, 0u, 0u, 0u}; }
        for (size_t i = gt; i < (size_t)(MP - M) * 256 / 8; i += GT) *(u32x4*)(ALR + (size_t)M * 256 + i * 8) = (u32x4){0u, 0u, 0u, 0u};
        for (size_t i = gt; i < (size_t)3 * (MP - M) * 1024 / 8; i += GT) { const size_t per = (size_t)(MP - M) * 1024 / 8; const size_t z = i / per, o = i % per;
            *(u32x4*)(Y + (z * MP + M) * 1024 + o * 8) = (u32x4){0u, 0u, 0u, 0u}; }
    }
#endif
    __syncthreads();
    grid.sync();

    for (int l = 0; l < DEPTH; ++l) {
        if (l > 0) {
            PHASE_IDS
            for (int r = gw; r < M; r += NGW) rms_row(H + (size_t)r * D, nullptr, norm_g + (size_t)l * D, XN + (size_t)r * D, lane);
            xcd_barrier(gbar);
        }
        {
            pg8::Gemm g{XN, WINT + (size_t)l * NP * D, MP, NP, D, 0, 0};
            pg8::Order S; S.init(MP, NP, 1, G, (int)blockIdx.x);
            EpiG1 E{PROJ, AF, IGFG, LB + l * 1024};
#ifndef NO_G1
            pg8::gemm_phase<EpiG1>(lds, g, S, E);
#endif
        }
        xcd_barrier(gbar);
#ifndef NO_R1
        { PHASE_IDS
#pragma unroll 2
        for (int r = gw; r < M; r += NGW) {
            const int b = r / T, t = r - b * T;
            const bf16_t* pr = PROJ + (size_t)r * NP;
#pragma unroll
            for (int it = 0; it < 2; ++it) {
                const int c8 = (it * 64 + lane) * 8;
                float o[8];
#pragma unroll
                for (int i = 0; i < 8; ++i) o[i] = 0.f;
#pragma unroll
                for (int j = 0; j < 4; ++j) {
                    if (t - 3 + j >= 0) {
                        float xv[8]; unpack8(*(const u32x4*)(pr - (size_t)(3 - j) * NP + C_BQ + c8), xv);
                        const float* wp = mconv + ((size_t)l * 4 + j) * 1024 + c8;
                        const f32x4 w0v = *(const f32x4*)wp, w1v = *(const f32x4*)(wp + 4);
#pragma unroll
                        for (int i = 0; i < 4; ++i) { o[i] += w0v[i] * xv[i]; o[4 + i] += w1v[i] * xv[4 + i]; }
                    }
                }
                const float sc = (c8 < 512) ? 0.08838834764831845f : 1.0f;
#pragma unroll
                for (int i = 0; i < 8; ++i) o[i] = siluf_(o[i]) * sc;
                *(u32x4*)(BQK + (size_t)r * 1024 + c8) = pack8(o);
            }
            if (lane < 8) {
                const float raw = IGFG[(size_t)r * 8 + lane];
                float o;
                if (lane < 4) o = raw + ig_b[l * 4 + lane];
                else { const float z = raw + fg_b[l * 4 + (lane - 4)]; o = fminf(z, 0.f) - __logf(1.0f + __expf(-fabsf(z))); }
                IL[(size_t)r * 8 + lane] = o;
            }
#pragma unroll
            for (int it = 0; it < 6; ++it) {
                const int c8 = (it * 64 + lane) * 8;
                float cur[8], prv[8], o[8];
                unpack8(*(const u32x4*)(pr + C_CR + c8), cur);
                if (t > 0) unpack8(*(const u32x4*)(pr - NP + C_CR + c8), prv);
                else {
#pragma unroll
                    for (int i = 0; i < 8; ++i) prv[i] = 0.f;
                }
                const float* mp = mu + (size_t)l * 3200 + c8;
                const f32x4 m0 = *(const f32x4*)mp, m1 = *(const f32x4*)(mp + 4);
#pragma unroll
                for (int i = 0; i < 4; ++i) { o[i] = cur[i] + (prv[i] - cur[i]) * m0[i]; o[4 + i] = cur[4 + i] + (prv[4 + i] - cur[4 + i]) * m1[i]; }
                *(u32x4*)(CRKV + (size_t)r * 3072 + c8) = pack8(o);
            }
            if (lane < 16) {
                const int c8 = lane * 8;
                float cur[8], prv[8], o[8];
                unpack8(*(const u32x4*)(pr + C_WD + c8), cur);
                if (t > 0) unpack8(*(const u32x4*)(pr - NP + C_WD + c8), prv);
                else {
#pragma unroll
                    for (int i = 0; i < 8; ++i) prv[i] = 0.f;
                }
                const float* mp = mu + (size_t)l * 3200 + 3072 + c8;
                const f32x4 m0 = *(const f32x4*)mp, m1 = *(const f32x4*)(mp + 4);
#pragma unroll
                for (int i = 0; i < 4; ++i) { o[i] = cur[i] + (prv[i] - cur[i]) * m0[i]; o[4 + i] = cur[4 + i] + (prv[4 + i] - cur[4 + i]) * m1[i]; }
                if (lane < 8) {
#pragma unroll
                    for (int i = 0; i < 8; ++i) o[i] = tanhf(o[i]);
                }
                *(u32x4*)(ALR + (size_t)r * 256 + c8) = pack8(o);
            } else if (lane < 32) {
                *(u32x4*)(ALR + (size_t)r * 256 + lane * 8) = (u32x4){0u, 0u, 0u, 0u};
            }
        } }
#endif
        xcd_barrier(gbar);
        {
            pg8::Gemm g{ALR, WLRT + (size_t)l * 2048 * 256, MT, 2048, 256, 0, 0};
            pg8::Order S; S.init(MT, 2048, 1, G, (int)blockIdx.x);
            EpiLR E{CW, CA, w0 + (size_t)l * 1024, a0 + (size_t)l * 1024};
#ifndef NO_G1B
            pg8::gemm_phase<EpiLR>(lds, g, S, E);
#endif
            for (int cb = (int)blockIdx.x; cb < 2048 / 16; cb += G) skinny_g1b(ldsf, ALR, WLRT + (size_t)l * 2048 * 256, w0 + (size_t)l * 1024, a0 + (size_t)l * 1024, CW, CA, cb * 16);
        }
        xcd_barrier(gbar);
        const LaCtx X{PROJ, AF, BQK, IL, (bf16_t*)(ws + WS_DSI), (bf16_t*)(ws + WS_DS), (float*)(ws + WS_DEC), (float*)(ws + WS_BEND), (float*)(ws + WS_MLOC), (float*)(ws + WS_MPREV), ORAW, DEN, MST};
        const RwCtx RX{CRKV, CW, CA, k_k + (size_t)l * 1024, k_a + (size_t)l * 1024, ws + WS_RWI, (bf16_t*)(ws + WS_SRW), ORAW};
#ifndef NO_RWA
        for (int it = (int)blockIdx.x; it < RW_ITEMS; it += G) rw_phaseA(lds, RX, it);
#endif
        for (int it = ((int)blockIdx.x + G - 32) % G; it < NITEMS_LA; it += G) la_phaseA(lds, X, it);
        xcd_barrier(gbar);
        la_scan(X);
#ifndef NO_RWB
        if ((int)blockIdx.x >= G - 32) rw_phaseB(lds, RX, (int)blockIdx.x - (G - 32));
#endif
        xcd_barrier(gbar);
#ifndef NO_RWC
        for (int it = (int)blockIdx.x; it < RW_ITEMS; it += G) rw_phaseC(lds, RX, it);
#endif
        for (int it = ((int)blockIdx.x + G - 32) % G; it < NITEMS_LA; it += G) la_phaseC(lds, X, it);
        xcd_barrier(gbar);
#ifndef NO_NORM
        { PHASE_IDS
        for (int r = gw; r < M; r += NGW) {
            const bf16_t* pr = PROJ + (size_t)r * NP;
            const int c0 = lane * 16;
            {
                float o[16]; float ss = 0.f;
#pragma unroll
                for (int j = 0; j < 2; ++j) { float t8[8]; unpack8(*(const u32x4*)(ORAW + (size_t)r * 3072 + c0 + 8 * j), t8);
#pragma unroll
                    for (int i = 0; i < 8; ++i) o[8 * j + i] = t8[i]; }
#pragma unroll
                for (int i = 0; i < 16; ++i) ss += o[i] * o[i];
                ss += __shfl_xor(ss, 1); ss += __shfl_xor(ss, 2); ss += __shfl_xor(ss, 4);
                const float rs = rsqrtf(ss * (1.0f / 128.0f) + 1e-6f);
#pragma unroll
                for (int hh = 0; hh < 2; ++hh) {
                    float z8[8], y8[8]; unpack8(*(const u32x4*)(pr + C_AZ + c0 + 8 * hh), z8);
#pragma unroll
                    for (int i = 0; i < 8; ++i) z8[i] = siluf_(z8[i]);
                    const float* gp = hgrn_g + (size_t)l * 1024 + c0 + 8 * hh;
#pragma unroll
                    for (int i = 0; i < 8; ++i) y8[i] = o[8 * hh + i] * rs * gp[i] * z8[i];
                    *(u32x4*)(Y + (size_t)r * 1024 + c0 + 8 * hh) = pack8(y8);
                }
            }
            {
                const int hd = lane >> 4;
                const float den = DEN[(size_t)r * 4 + hd], mm = MST[(size_t)r * 4 + hd];
                const float inv = 1.0f / fmaxf(fabsf(den), expf(-mm));
                float o[16]; float s1 = 0.f;
#pragma unroll
                for (int j = 0; j < 2; ++j) { float t8[8]; unpack8(*(const u32x4*)(ORAW + (size_t)r * 3072 + 1024 + c0 + 8 * j), t8);
#pragma unroll
                    for (int i = 0; i < 8; ++i) o[8 * j + i] = t8[i] * inv; }
#pragma unroll
                for (int i = 0; i < 16; ++i) s1 += o[i];
                s1 += __shfl_xor(s1, 1); s1 += __shfl_xor(s1, 2); s1 += __shfl_xor(s1, 4); s1 += __shfl_xor(s1, 8);
                const float mean = s1 * (1.0f / 256.0f);
                float s2 = 0.f;
#pragma unroll
                for (int i = 0; i < 16; ++i) { o[i] -= mean; s2 += o[i] * o[i]; }
                s2 += __shfl_xor(s2, 1); s2 += __shfl_xor(s2, 2); s2 += __shfl_xor(s2, 4); s2 += __shfl_xor(s2, 8);
                const float rs = rsqrtf(s2 * (1.0f / 256.0f) + 1e-6f);
#pragma unroll
                for (int hh = 0; hh < 2; ++hh) {
                    float og[8], z8[8], y8[8]; unpack8(*(const u32x4*)(pr + C_BO + c0 + 8 * hh), og); unpack8(*(const u32x4*)(pr + C_BZ + c0 + 8 * hh), z8);
#pragma unroll
                    for (int i = 0; i < 8; ++i) { og[i] = sigmoidf_(og[i]); z8[i] = siluf_(z8[i]); }
                    const float* gp = mnorm_g + (size_t)l * 1024 + c0 + 8 * hh;
#pragma unroll
                    for (int i = 0; i < 8; ++i) y8[i] = o[8 * hh + i] * rs * gp[i] * og[i] * z8[i];
                    *(u32x4*)(Y + ((size_t)MP + r) * 1024 + c0 + 8 * hh) = pack8(y8);
                }
            }
            {
                float o[16]; float s1 = 0.f;
#pragma unroll
                for (int j = 0; j < 2; ++j) { float t8[8]; unpack8(*(const u32x4*)(ORAW + (size_t)r * 3072 + 2048 + c0 + 8 * j), t8);
#pragma unroll
                    for (int i = 0; i < 8; ++i) o[8 * j + i] = t8[i]; }
#pragma unroll
                for (int i = 0; i < 16; ++i) s1 += o[i];
                s1 += __shfl_xor(s1, 1); s1 += __shfl_xor(s1, 2);
                const float mean = s1 * (1.0f / 64.0f);
                float s2 = 0.f;
#pragma unroll
                for (int i = 0; i < 16; ++i) { o[i] -= mean; s2 += o[i] * o[i]; }
                s2 += __shfl_xor(s2, 1); s2 += __shfl_xor(s2, 2);
                const float rs = rsqrtf(s2 * (1.0f / 64.0f) + 64e-5f);
                const bf16_t* cr = CRKV + (size_t)r * 3072;
                float rr[16], kk[16], vv[16];
#pragma unroll
                for (int hh = 0; hh < 2; ++hh) {
                    float t8[8];
                    unpack8(*(const u32x4*)(cr + c0 + 8 * hh), t8);
#pragma unroll
                    for (int i = 0; i < 8; ++i) rr[8 * hh + i] = t8[i];
                    unpack8(*(const u32x4*)(cr + 1024 + c0 + 8 * hh), t8);
#pragma unroll
                    for (int i = 0; i < 8; ++i) kk[8 * hh + i] = t8[i];
                    unpack8(*(const u32x4*)(cr + 2048 + c0 + 8 * hh), t8);
#pragma unroll
                    for (int i = 0; i < 8; ++i) vv[8 * hh + i] = t8[i];
                }
                float bs = 0.f;
#pragma unroll
                for (int i = 0; i < 16; ++i) { const float aa = bf1(CA[(size_t)r * 1024 + c0 + i]); const float kp = kk[i] * (1.0f + (aa - 1.0f) * k_a[(size_t)l * 1024 + c0 + i]);
                    bs += rr[i] * kp * r_k[(size_t)l * 1024 + c0 + i]; }
                bs += __shfl_xor(bs, 1); bs += __shfl_xor(bs, 2);
#pragma unroll
                for (int hh = 0; hh < 2; ++hh) {
                    float z8[8], y8[8]; unpack8(*(const u32x4*)(pr + C_CZ + c0 + 8 * hh), z8);
#pragma unroll
                    for (int i = 0; i < 8; ++i) z8[i] = siluf_(z8[i]);
                    const float* gp = ln_g + (size_t)l * 1024 + c0 + 8 * hh; const float* bp = ln_b + (size_t)l * 1024 + c0 + 8 * hh;
#pragma unroll
                    for (int i = 0; i < 8; ++i) y8[i] = (o[8 * hh + i] * rs * gp[i] + bp[i] + bs * vv[8 * hh + i]) * z8[i];
                    *(u32x4*)(Y + ((size_t)2 * MP + r) * 1024 + c0 + 8 * hh) = pack8(y8);
                }
            }
        } }
#endif
        xcd_barrier(gbar);
        {
            pg8::Gemm g{Y, WBRT + (size_t)l * 3 * D * 1024, MT, D, 1024, (size_t)MP * 1024 * 2, (size_t)D * 1024 * 2};
            pg8::Order S; S.init(MT, D, 3, G, (int)blockIdx.x);
            EpiG2 E{PROJ, MERGED};
#ifndef NO_G2
            pg8::gemm_phase<EpiG2>(lds, g, S, E);
#endif
            for (int cb = (int)blockIdx.x; cb < D / 16; cb += G) skinny_g2(ldsf, Y, WBRT + (size_t)l * 3 * D * 1024, PROJ, MERGED, cb * 16);
        }
        xcd_barrier(gbar);
        {
            pg8::Gemm g{MERGED, WOUTT + (size_t)l * D * D, MT, D, D, 0, 0};
            pg8::Order S; S.init(MT, D, 1, G, (int)blockIdx.x);
            EpiG3 E{H};
#ifndef NO_G3
            pg8::gemm_phase<EpiG3>(lds, g, S, E);
#endif
            for (int cb = (int)blockIdx.x; cb < D / 16; cb += G) skinny_g3(ldsf, MERGED, WOUTT + (size_t)l * D * D, H, cb * 16);
        }
        xcd_barrier(gbar);
    }
    PHASE_IDS
    for (int r = gw; r < M; r += NGW) {
        const int b = r / T, t = r - b * T;
        if (t < NMETA) continue;
        const float* src = H + (size_t)r * D;
        float* dst = args.out + ((size_t)b * SEQ + (t - NMETA)) * D;
        f32x4 v[8]; float ss = 0.f;
#pragma unroll
        for (int j = 0; j < 8; ++j) { v[j] = *(const f32x4*)(src + 256 * j + 4 * lane); ss += (v[j][0] * v[j][0] + v[j][1] * v[j][1]) + (v[j][2] * v[j][2] + v[j][3] * v[j][3]); }
        const float rs = rsqrtf(wave_sum(ss) * (1.0f / D) + 1e-6f);
#pragma unroll
        for (int j = 0; j < 8; ++j) { const f32x4 gg = *(const f32x4*)(fin_g + 256 * j + 4 * lane);
            *(f32x4*)(dst + 256 * j + 4 * lane) = (f32x4){v[j][0] * rs * gg[0], v[j][1] * rs * gg[1], v[j][2] * rs * gg[2], v[j][3] * rs * gg[3]}; }
    }
}

extern "C" void kernel_launch(void* const* d_in, const int* in_sizes, int n_in, void* d_out, int out_size, void* d_ws, size_t ws_size, hipStream_t stream) {
    static int grid = 0;
    if (grid == 0) {
        if (n_in != 23 || ws_size < WS_END) { fprintf(stderr, "kernel_launch: unexpected n_in %d or workspace %zu < %zu\n", n_in, ws_size, (size_t)WS_END); grid = -1; return; }
        int dev = 0, cus = 0, per_cu = 0;
        (void)hipGetDevice(&dev);
        (void)hipDeviceGetAttribute(&cus, hipDeviceAttributeMultiprocessorCount, dev);
        (void)hipFuncSetAttribute((const void*)fwd_megakernel, hipFuncAttributeMaxDynamicSharedMemorySize, LDS_BYTES);
        (void)hipOccupancyMaxActiveBlocksPerMultiprocessor(&per_cu, (const void*)fwd_megakernel, NTHREADS, LDS_BYTES);
        if (per_cu < 1) per_cu = 1;
        grid = cus * per_cu;
        fprintf(stderr, "kernel_launch: grid %d (cus %d x %d), ws %zu need %zu\n", grid, cus, per_cu, ws_size, (size_t)WS_END);
    }
    if (grid < 0) return;
    Args a{};
    for (int i = 0; i < 23; ++i) a.in[i] = (const float*)d_in[i];
    a.out = (float*)d_out; a.ws = (unsigned char*)d_ws;
    (void)hipMemsetAsync((unsigned char*)d_ws + WS_BAR, 0, (size_t)XCD_BAR_WORDS * 4, stream);
    void* kargs[] = {&a};
    hipError_t e = hipLaunchCooperativeKernel((const void*)fwd_megakernel, dim3(grid), dim3(NTHREADS), kargs, LDS_BYTES, stream);
    if (e != hipSuccess) fprintf(stderr, "kernel_launch: cooperative launch failed: %s (grid %d)\n", hipGetErrorString(e), grid);
}
```
